# Optimizing an MI355X kernel written in HIP

```python
import math
import jax, jax.numpy as jnp
from jax import lax
import numpy as np

D_MODEL = 1024
BATCH = 8
SEQ = 8192
DEPTH = 2
DEC_BATCH = 16
DEC_SEQ = 2048
PAST_LEN = 128

GRID_W = 64
N_META = 16
WIN_R = 8
WIN_C = 16
NA_HEADS = 6
NA_HD = 64
DA_HEADS = 6
DA_HD = 32
DA_VD = 64
DA_ROT = DA_HD // 4
MLA_HEADS = 4
MLA_NOPE = 64
MLA_ROPE = 32
MLA_VD = 64
Q_LORA = 256
KV_LORA = 128
ROPE_THETA = 500000.0
D_FF = 2816
Q_BLOCK = 128
EPS = 1e-6
NA_W = NA_HEADS * NA_HD
DA_W = DA_HEADS * DA_VD
MLA_W = MLA_HEADS * MLA_VD
MIX_W = NA_W + DA_W + MLA_W
DA_QK_W = DA_HEADS * 2 * DA_HD
IN_W = 3 * NA_W + 2 * DA_QK_W + DA_W + Q_LORA + KV_LORA + MLA_ROPE

kernel_name = 'hybrid_bidir_encoder_na_diff_mla'


def rms_norm(x, g):
    xf = x.astype(jnp.float32)
    y = xf * lax.rsqrt(jnp.mean(xf * xf, axis=-1, keepdims=True) + EPS)
    return (y * g.astype(jnp.float32)).astype(x.dtype)


def swiglu(x, w_gate, w_up, w_down):
    return (jax.nn.silu(x @ w_gate) * (x @ w_up)) @ w_down


def rope_tables(pos, dim, dtype):
    inv = ROPE_THETA ** (-(jnp.arange(0, dim, 2, dtype=jnp.float32) / dim))
    ang = pos[:, None] * inv[None, :]
    return jnp.cos(ang).astype(dtype), jnp.sin(ang).astype(dtype)


def apply_rope(x, cos, sin):
    half = x.shape[-1] // 2
    x1, x2 = x[..., :half], x[..., half:]
    return jnp.concatenate([x1 * cos - x2 * sin, x2 * cos + x1 * sin], axis=-1)


def sweep_queries(attend, qs):
    meta_out = attend(*[q[:, :N_META] for q in qs])
    real = [q[:, N_META:] for q in qs]
    b, n = real[0].shape[0], real[0].shape[1]
    nb = n // Q_BLOCK
    blocks = tuple(jnp.moveaxis(q.reshape((b, nb, Q_BLOCK) + q.shape[2:]), 1, 0) for q in real)
    out = lax.map(lambda xs: attend(*xs), blocks)
    out = jnp.moveaxis(out, 0, 1).reshape((b, n) + out.shape[3:])
    return jnp.concatenate([meta_out, out], axis=1)


def neighbourhood_attention(q, k, v, rel_bias, rows):
    b = q.shape[0]
    n = rows * GRID_W
    wr = min(WIN_R, rows)
    scale = NA_HD ** -0.5
    q = q.reshape(b, N_META + n, NA_HEADS, NA_HD)
    k = k.reshape(b, N_META + n, NA_HEADS, NA_HD)
    v = v.reshape(b, N_META + n, NA_HEADS, NA_HD)
    qm, km, vm = q[:, :N_META], k[:, :N_META], v[:, :N_META]
    sm = jnp.einsum('bqhd,bkhd->bhqk', qm, km, preferred_element_type=jnp.float32) * scale
    om = jnp.einsum('bhqk,bkhd->bqhd', jax.nn.softmax(sm, axis=-1).astype(v.dtype), vm)
    qg = q[:, N_META:].reshape(b, rows, GRID_W, NA_HEADS, NA_HD)
    kg = k[:, N_META:].reshape(b, rows, GRID_W, NA_HEADS, NA_HD)
    vg = v[:, N_META:].reshape(b, rows, GRID_W, NA_HEADS, NA_HD)
    row_start = jnp.clip(jnp.arange(rows) - WIN_R // 2, 0, rows - wr)
    col_idx = jnp.clip(jnp.arange(GRID_W) - WIN_C // 2, 0, GRID_W - WIN_C)[:, None] + jnp.arange(WIN_C)[None, :]
    col_off = col_idx - jnp.arange(GRID_W)[:, None] + (WIN_C - 1)
    bias_c = rel_bias[:, :, col_off]

    def row_block(r):
        rs = row_start[r]
        q_row = lax.dynamic_index_in_dim(qg, r, axis=1, keepdims=False)
        k_win = lax.dynamic_slice_in_dim(kg, rs, wr, axis=1)[:, :, col_idx]
        v_win = lax.dynamic_slice_in_dim(vg, rs, wr, axis=1)[:, :, col_idx]
        bias = bias_c[:, rs + jnp.arange(wr) - r + (WIN_R - 1)]
        s_win = jnp.einsum('bchd,bwckhd->bhcwk', q_row, k_win, preferred_element_type=jnp.float32) * scale
        s_win = s_win + jnp.transpose(bias, (0, 2, 1, 3)).astype(jnp.float32)
        s_meta = jnp.einsum('bchd,bmhd->bhcm', q_row, km, preferred_element_type=jnp.float32) * scale
        s = jnp.concatenate([s_win.reshape(b, NA_HEADS, GRID_W, wr * WIN_C), s_meta], axis=-1)
        p = jax.nn.softmax(s, axis=-1).astype(v.dtype)
        p_win = p[..., :wr * WIN_C].reshape(b, NA_HEADS, GRID_W, wr, WIN_C)
        p_meta = p[..., wr * WIN_C:]
        return (jnp.einsum('bhcwk,bwckhd->bchd', p_win, v_win)
                + jnp.einsum('bhcm,bmhd->bchd', p_meta, vm))

    og = lax.map(row_block, jnp.arange(rows))
    og = jnp.moveaxis(og, 0, 1).reshape(b, n, NA_W)
    return jnp.concatenate([om.reshape(b, N_META, NA_W), og], axis=1)


def differential_attention(q, k, v, lam_params, subln_g, layer, cos, sin):
    b, t = q.shape[0], q.shape[1]
    q = q.reshape(b, t, DA_HEADS, 2, DA_HD)
    k = k.reshape(b, t, DA_HEADS, 2, DA_HD)
    v = v.reshape(b, t, DA_HEADS, DA_VD)
    c, s_ = cos[:, None, None, :], sin[:, None, None, :]
    q = jnp.concatenate([apply_rope(q[..., :DA_ROT], c, s_), q[..., DA_ROT:]], axis=-1)
    k = jnp.concatenate([apply_rope(k[..., :DA_ROT], c, s_), k[..., DA_ROT:]], axis=-1)
    lp = lam_params.astype(jnp.float32)
    lam_init = 0.8 - 0.6 * math.exp(-0.3 * layer)
    lam = jnp.exp(jnp.sum(lp[0] * lp[1])) - jnp.exp(jnp.sum(lp[2] * lp[3])) + lam_init
    scale = DA_HD ** -0.5

    def attend(qb):
        tq = qb.shape[1]
        s = jnp.einsum('bqhmd,bkhmd->bhmqk', qb, k, preferred_element_type=jnp.float32) * scale
        p = jax.nn.softmax(s, axis=-1)
        a = (p[:, :, 0] - lam * p[:, :, 1]).astype(v.dtype)
        o = jnp.einsum('bhqk,bkhe->bqhe', a, v)
        o = rms_norm(o, subln_g) * (1.0 - lam_init)
        return o.reshape(b, tq, DA_W)

    return sweep_queries(attend, (q,))


def latent_attention(cq, ckv, krope, q_norm_g, kv_norm_g, w_uq, w_ukv, cos, sin):
    b, t = cq.shape[0], cq.shape[1]
    q = (rms_norm(cq, q_norm_g) @ w_uq).reshape(b, t, MLA_HEADS, MLA_NOPE + MLA_ROPE)
    q_nope = q[..., :MLA_NOPE]
    q_rope = apply_rope(q[..., MLA_NOPE:], cos[:, None, :], sin[:, None, :])
    kv = (rms_norm(ckv, kv_norm_g) @ w_ukv).reshape(b, t, MLA_HEADS, MLA_NOPE + MLA_VD)
    k_nope, v = kv[..., :MLA_NOPE], kv[..., MLA_NOPE:]
    k_rope = apply_rope(krope, cos, sin)
    scale = (MLA_NOPE + MLA_ROPE) ** -0.5

    def attend(qn, qr):
        tq = qn.shape[1]
        s = (jnp.einsum('bqhd,bkhd->bhqk', qn, k_nope, preferred_element_type=jnp.float32)
             + jnp.einsum('bqhr,bkr->bhqk', qr, k_rope, preferred_element_type=jnp.float32)) * scale
        p = jax.nn.softmax(s, axis=-1).astype(v.dtype)
        return jnp.einsum('bhqk,bkhe->bqhe', p, v).reshape(b, tq, MLA_W)

    return sweep_queries(attend, (q_nope, q_rope))


def trunk(x, meta_tokens, norm_g, final_norm_g, ffn_w_gate, ffn_w_up, ffn_w_down, w_in, w_out,
          na_rel_bias, da_lambda, da_subln_g, mla_q_norm_g, mla_kv_norm_g, mla_w_uq, mla_w_ukv):
    b, n, _ = x.shape
    rows = n // GRID_W
    meta = jnp.broadcast_to(meta_tokens[None].astype(x.dtype), (b, N_META, D_MODEL))
    h = jnp.concatenate([meta, x], axis=1)
    pos = jnp.arange(N_META + n, dtype=jnp.float32)
    cos_da, sin_da = rope_tables(pos, DA_ROT, x.dtype)
    cos_mla, sin_mla = rope_tables(pos, MLA_ROPE, x.dtype)
    sizes = (NA_W, NA_W, NA_W, DA_QK_W, DA_QK_W, DA_W, Q_LORA, KV_LORA, MLA_ROPE)
    split_idx = np.cumsum(sizes)[:-1].tolist()
    for l in range(DEPTH):
        h = h + 0.5 * swiglu(rms_norm(h, norm_g[l, 0]), ffn_w_gate[l, 0], ffn_w_up[l, 0], ffn_w_down[l, 0])
        u = rms_norm(h, norm_g[l, 1]) @ w_in[l]
        na_q, na_k, na_v, da_q, da_k, da_v, mla_cq, mla_ckv, mla_kr = jnp.split(u, split_idx, axis=-1)
        o_na = neighbourhood_attention(na_q, na_k, na_v, na_rel_bias[l], rows)
        o_da = differential_attention(da_q, da_k, da_v, da_lambda[l], da_subln_g[l], l, cos_da, sin_da)
        o_mla = latent_attention(mla_cq, mla_ckv, mla_kr, mla_q_norm_g[l], mla_kv_norm_g[l],
                                 mla_w_uq[l], mla_w_ukv[l], cos_mla, sin_mla)
        h = h + jnp.concatenate([o_na, o_da, o_mla], axis=-1) @ w_out[l]
        h = h + 0.5 * swiglu(rms_norm(h, norm_g[l, 2]), ffn_w_gate[l, 1], ffn_w_up[l, 1], ffn_w_down[l, 1])
    return rms_norm(h, final_norm_g)[:, N_META:]


def setup_inputs(seed: int = 0) -> dict:
    key = jax.random.key(seed)
    ks = jax.random.split(key, 17)
    nrm = lambda k, shape, s: jax.random.normal(k, shape, jnp.float32) * s
    return {
        'x_prompt': nrm(ks[0], (BATCH, SEQ, D_MODEL), 1.0),
        'x_sample': nrm(ks[1], (DEC_BATCH, DEC_SEQ, D_MODEL), 1.0),
        'meta_tokens': nrm(ks[2], (N_META, D_MODEL), 1.0),
        'norm_g': 1.0 + nrm(ks[3], (DEPTH, 3, D_MODEL), 0.05),
        'final_norm_g': 1.0 + nrm(ks[4], (D_MODEL,), 0.05),
        'ffn_w_gate': nrm(ks[5], (DEPTH, 2, D_MODEL, D_FF), D_MODEL ** -0.5),
        'ffn_w_up': nrm(ks[6], (DEPTH, 2, D_MODEL, D_FF), D_MODEL ** -0.5),
        'ffn_w_down': nrm(ks[7], (DEPTH, 2, D_FF, D_MODEL), D_FF ** -0.5),
        'w_in': nrm(ks[8], (DEPTH, D_MODEL, IN_W), D_MODEL ** -0.5),
        'w_out': nrm(ks[9], (DEPTH, MIX_W, D_MODEL), MIX_W ** -0.5),
        'na_rel_bias': nrm(ks[10], (DEPTH, NA_HEADS, 2 * WIN_R - 1, 2 * WIN_C - 1), 0.1),
        'da_lambda': nrm(ks[11], (DEPTH, 4, DA_HD), 0.1),
        'da_subln_g': 1.0 + nrm(ks[12], (DEPTH, DA_VD), 0.05),
        'mla_q_norm_g': 1.0 + nrm(ks[13], (DEPTH, Q_LORA), 0.05),
        'mla_kv_norm_g': 1.0 + nrm(ks[14], (DEPTH, KV_LORA), 0.05),
        'mla_w_uq': nrm(ks[15], (DEPTH, Q_LORA, MLA_HEADS * (MLA_NOPE + MLA_ROPE)), Q_LORA ** -0.5),
        'mla_w_ukv': nrm(ks[16], (DEPTH, KV_LORA, MLA_HEADS * (MLA_NOPE + MLA_VD)), KV_LORA ** -0.5),
    }


def reference(x_prompt, x_sample, meta_tokens, norm_g, final_norm_g, ffn_w_gate, ffn_w_up, ffn_w_down,
              w_in, w_out, na_rel_bias, da_lambda, da_subln_g, mla_q_norm_g, mla_kv_norm_g, mla_w_uq, mla_w_ukv):
    y_prompt = trunk(x_prompt, meta_tokens, norm_g, final_norm_g, ffn_w_gate, ffn_w_up, ffn_w_down, w_in, w_out,
                     na_rel_bias, da_lambda, da_subln_g, mla_q_norm_g, mla_kv_norm_g, mla_w_uq, mla_w_ukv)
    y_sample = trunk(x_sample, meta_tokens, norm_g, final_norm_g, ffn_w_gate, ffn_w_up, ffn_w_down, w_in, w_out,
                     na_rel_bias, da_lambda, da_subln_g, mla_q_norm_g, mla_kv_norm_g, mla_w_uq, mla_w_ukv)
    return (y_prompt, y_sample)
```

```cpp
#include <hip/hip_runtime.h>
#include <hip/hip_cooperative_groups.h>
#include <cstdio>
#include <cstdint>
namespace cg = cooperative_groups;
#ifndef PH
#define PH 1023
#endif

#define LAS __attribute__((address_space(3)))
typedef unsigned short bf16_t;
typedef short bf16x8 __attribute__((ext_vector_type(8)));
typedef short s16x4 __attribute__((ext_vector_type(4)));
typedef float f32x4 __attribute__((ext_vector_type(4)));
typedef float f32x2 __attribute__((ext_vector_type(2)));
typedef float f32x16 __attribute__((ext_vector_type(16)));
typedef unsigned u32x4 __attribute__((ext_vector_type(4)));
typedef unsigned u32x2 __attribute__((ext_vector_type(2)));
typedef __bf16 bf16x2_t __attribute__((ext_vector_type(2)));
#define DI __device__ __forceinline__

constexpr int D = 1024, DFF = 2816, INW = 2720, INP = 2816;
constexpr int NREAL = 98304, MR = 98688, MP = 98816;
constexpr int METAB = 98304;
constexpr float EPS = 1e-6f;
constexpr int U_NAQ = 0, U_NAK = 384, U_NAV = 768, U_DAQ = 1152, U_DAK = 1536, U_DAV = 1920, U_CQ = 2304, U_CKV = 2560, U_KR = 2688;
constexpr size_t MiB = 1u << 20;
constexpr size_t WS_CTL = 0;
constexpr size_t WS_HMETA = 1 * MiB;
constexpr size_t WS_TABM = 3 * MiB;
constexpr size_t WS_TABD = WS_TABM + 2 * 8208 * 16 * 4;
constexpr size_t WS_WGU = 5 * MiB;
constexpr size_t WS_WDN = WS_WGU + 4ull * 5632 * 1024 * 2;
constexpr size_t WS_WIN = WS_WDN + 4ull * 1024 * 2816 * 2;
constexpr size_t WS_WOUT = WS_WIN + 2ull * 2816 * 1024 * 2;
constexpr size_t WS_WMLA = WS_WOUT + 2ull * 1024 * 1024 * 2;
constexpr size_t WS_XO = 89 * MiB;
constexpr size_t WS_QKVM = WS_XO + (size_t)MP * 1024 * 2;
constexpr size_t WS_BIG = WS_QKVM + (size_t)MP * 1024 * 2;
constexpr size_t WS_END = WS_BIG + (size_t)MP * 2816 * 2;
static_assert(WS_WMLA + 2ull * 1024 * 384 * 2 <= WS_XO, "ws map");
static_assert(WS_END <= 1024 * MiB, "ws map fits 1 GiB");

constexpr int LDS_BYTES = 131072 + 1024 + 11264 + 256 + 4096;
constexpr int EPIU_X_OFF = 131072 + 1024 + 11264 + 256;

DI unsigned cvtpk(float lo, float hi) { f32x2 v = {lo, hi}; bf16x2_t b = __builtin_convertvector(v, bf16x2_t); return __builtin_bit_cast(unsigned, b); }
DI float bf2f(unsigned short x) { return __uint_as_float((unsigned)x << 16); }
DI float wave_sum(float v) {
#pragma unroll
    for (int o = 1; o < 64; o <<= 1) v += __shfl_xor(v, o);
    return v;
}
DI int opaque_tid() { int t = threadIdx.x; asm volatile("" : "+v"(t)); return t; }
DI int row_pos(int r) { return r < 65536 ? 16 + (r & 8191) : (r < NREAL ? 16 + (r & 2047) : ((r - NREAL) & 15)); }
DI float swapmax(float m) { auto rr = __builtin_amdgcn_permlane32_swap(__float_as_uint(m), __float_as_uint(m), false, false); return fmaxf(__uint_as_float(rr[0]), __uint_as_float(rr[1])); }
DI float swapsum(float m) { auto rr = __builtin_amdgcn_permlane32_swap(__float_as_uint(m), __float_as_uint(m), false, false); return __uint_as_float(rr[0]) + __uint_as_float(rr[1]); }

namespace pg8 {
constexpr int BM = 256, BK = 64, HALF = 128, HTB = HALF * BK * 2, STAGE_BYTES = 8 * HTB, NXCD = 8, WGM = 8;
DI int lds_byte(int r, int c) { const int st = (r >> 4) * 2 + (c >> 5), rr = r & 15, cc = c & 31, ob = rr * 64 + cc * 2; return st * 1024 + (ob ^ (((ob >> 9) & 1) << 5)); }
DI void stage_rc(int b, int& R, int& C) { const int st = b / 1024, sb = b % 1024, swz = sb ^ (((sb >> 9) & 1) << 5); R = (st >> 1) * 16 + swz / 64; C = (st & 1) * 32 + (swz % 64) / 2; }
DI int perm32(int rho) { const int n = rho >> 4, i = rho & 15; return 8 * (i >> 2) + 4 * n + (i & 3); }
struct Unit { int pm, pn; };
struct Gemm { const bf16_t* A; const bf16_t* Bt; int M, N, K, lda; };
struct StaticOrder {
    int nM, nN, nwg, G, c;
    DI void init(int M, int N, int G_, int c_) { nM = M / BM; nN = N / BM; nwg = nM * nN; G = G_; c = c_; }
    DI bool next(int i, Unit& u) const {
        const long L = (long)i * G + c; if (L >= nwg) return false;
        int wgid = (int)L; { const int q = nwg / NXCD, r = nwg % NXCD, xcd = wgid % NXCD, off = wgid / NXCD; wgid = (xcd < r ? xcd * (q + 1) : r * (q + 1) + (xcd - r) * q) + off; }
        const int nig = WGM * nN, gid = wgid / nig, fm = gid * WGM, gsz = (nM - fm) < WGM ? (nM - fm) : WGM;
        u.pm = fm + ((wgid % nig) % gsz); u.pn = (wgid % nig) / gsz; return true;
    }
};
struct EpiBf16 {
    static constexpr bool PERM = true;
    bf16_t* O; int ldc;
    DI void operator()(const f32x4 (&acc)[2][2][4][2], const Unit& u, int wr, int wc, int fr, int fq) const {
        const int row0 = u.pm * BM + wr * 64 + fr, col0 = u.pn * BM + wc * 32 + 8 * fq;
#pragma unroll
        for (int ai = 0; ai < 2; ++ai)
#pragma unroll
            for (int m = 0; m < 4; ++m) { bf16_t* rowp = O + (size_t)(row0 + ai * HALF + m * 16) * ldc + col0;
#pragma unroll
                for (int bj = 0; bj < 2; ++bj) { const f32x4 v0 = acc[ai][bj][m][0], v1 = acc[ai][bj][m][1];
                    u32x4 w; w.x = cvtpk(v0[0], v0[1]); w.y = cvtpk(v0[2], v0[3]); w.z = cvtpk(v1[0], v1[1]); w.w = cvtpk(v1[2], v1[3]);
                    *(u32x4*)(rowp + bj * HALF) = w; }
                asm volatile("" ::: "memory"); }
    }
};
struct EpiU {
    static constexpr bool PERM = true;
    bf16_t* O; const float* gq; const float* gkv; const float* tdc; const float* tds; const float* tmc; const float* tms; LAS float* X;
    DI void operator()(f32x4 (&acc)[2][2][4][2], const Unit& u, int wr, int wc, int fr, int fq) const {
        const int pn = u.pn, row0 = u.pm * BM + wr * 64 + fr, col0 = pn * BM + wc * 32 + 8 * fq;
        const bool normt = (pn == 9 || pn == 10);
        if (normt) {
            const int nbj = (pn == 9) ? 2 : 1;
#pragma unroll
            for (int ai = 0; ai < 2; ++ai)
#pragma unroll
                for (int m = 0; m < 4; ++m) { float ss = 0.f;
#pragma unroll
                    for (int bj = 0; bj < 2; ++bj) if (bj < nbj) {
#pragma unroll
                        for (int n = 0; n < 2; ++n) { const f32x4 v = acc[ai][bj][m][n]; ss += (v[0] * v[0] + v[1] * v[1]) + (v[2] * v[2] + v[3] * v[3]); } }
                    ss += __shfl_xor(ss, 16); ss += __shfl_xor(ss, 32);
                    if (fq == 0) X[(ai * HALF + wr * 64 + m * 16 + fr) * 4 + wc] = ss; }
            asm volatile("s_waitcnt lgkmcnt(0)" ::: "memory"); __builtin_amdgcn_s_barrier(); asm volatile("" ::: "memory");
        }
        const bool da_t0 = (pn == 5 || pn == 6 || pn == 7), da_t1 = (pn == 4 || pn == 5 || pn == 6);
#pragma unroll
        for (int ai = 0; ai < 2; ++ai)
#pragma unroll
            for (int m = 0; m < 4; ++m) { const int row = row0 + ai * HALF + m * 16; bf16_t* rowp = O + (size_t)row * INP + col0;
                const int pos = row < 65536 ? 16 + (row & 8191) : (row < NREAL ? 16 + (row & 2047) : ((row - NREAL) & 15));
                float rs = 1.0f;
                if (normt) { const f32x4 pr = *(const LAS f32x4*)(X + (ai * HALF + wr * 64 + m * 16 + fr) * 4);
                    rs = 1.0f / sqrtf(((pr[0] + pr[1]) + (pr[2] + pr[3])) * (pn == 9 ? (1.0f / 256.0f) : (1.0f / 128.0f)) + 1e-6f); }
#pragma unroll
                for (int bj = 0; bj < 2; ++bj) { f32x4 v0 = acc[ai][bj][m][0], v1 = acc[ai][bj][m][1];
                    if (pn == 9 || (pn == 10 && bj == 0)) {
                        const float* gp = (pn == 9 ? gq + bj * HALF : gkv) + wc * 32 + 8 * fq;
                        v0 = v0 * rs * *(const f32x4*)gp; v1 = v1 * rs * *(const f32x4*)(gp + 4);
                    } else if ((bj == 0 && da_t0) || (bj == 1 && da_t1)) {
                        const f32x4 c = *(const f32x4*)(tdc + pos * 4), sn = *(const f32x4*)(tds + pos * 4);
                        const f32x4 y0 = v0 * c - v1 * sn, y1 = v1 * c + v0 * sn;
                        if (fq == 0) { v0 = y0; v1 = y1; }
                    } else if (pn == 10 && bj == 1 && wc == 0) {
                        const int fi = 8 * (fq & 1);
                        const f32x4 c0 = *(const f32x4*)(tmc + pos * 16 + fi), c1 = *(const f32x4*)(tmc + pos * 16 + fi + 4), s0 = *(const f32x4*)(tms + pos * 16 + fi), s1 = *(const f32x4*)(tms + pos * 16 + fi + 4);
                        f32x4 p0, p1;
#pragma unroll
                        for (int e = 0; e < 4; ++e) { p0[e] = __shfl_xor(v0[e], 32); p1[e] = __shfl_xor(v1[e], 32); }
                        if (fq < 2) { v0 = v0 * c0 - p0 * s0; v1 = v1 * c1 - p1 * s1; }
                        else        { v0 = v0 * c0 + p0 * s0; v1 = v1 * c1 + p1 * s1; }
                    }
                    u32x4 w; w.x = cvtpk(v0[0], v0[1]); w.y = cvtpk(v0[2], v0[3]); w.z = cvtpk(v1[0], v1[1]); w.w = cvtpk(v1[2], v1[3]);
                    *(u32x4*)(rowp + bj * HALF) = w; }
                asm volatile("" ::: "memory"); }
    }
};
DI float silu_mul(float g, float u) { return g * u * __builtin_amdgcn_rcpf(1.0f + __builtin_amdgcn_exp2f(-1.4426950408889634f * g)); }
struct EpiSwiGLU {
    static constexpr bool PERM = true;
    bf16_t* O; int ldc;
    DI void operator()(const f32x4 (&acc)[2][2][4][2], const Unit& u, int wr, int wc, int fr, int fq) const {
        const int row0 = u.pm * BM + wr * 64 + fr, col0 = u.pn * HALF + wc * 32 + 8 * fq;
#pragma unroll
        for (int ai = 0; ai < 2; ++ai)
#pragma unroll
            for (int m = 0; m < 4; ++m) { bf16_t* rowp = O + (size_t)(row0 + ai * HALF + m * 16) * ldc + col0;
                const f32x4 g0 = acc[ai][0][m][0], g1 = acc[ai][0][m][1], u0 = acc[ai][1][m][0], u1 = acc[ai][1][m][1];
                u32x4 w; w.x = cvtpk(silu_mul(g0[0], u0[0]), silu_mul(g0[1], u0[1])); w.y = cvtpk(silu_mul(g0[2], u0[2]), silu_mul(g0[3], u0[3]));
                w.z = cvtpk(silu_mul(g1[0], u1[0]), silu_mul(g1[1], u1[1])); w.w = cvtpk(silu_mul(g1[2], u1[2]), silu_mul(g1[3], u1[3]));
                __builtin_nontemporal_store(w, (u32x4*)rowp); asm volatile("" ::: "memory"); }
    }
};
struct EpiResid {
    static constexpr bool PERM = false;
    float* hmain; float* hmeta_adj; float s; const float* xp; const float* xs_adj;
    DI void operator()(const f32x4 (&acc)[2][2][4][2], const Unit& u, int wr, int wc, int fr, int fq) const {
        const int row0 = u.pm * BM + wr * 64 + fr, col0 = u.pn * BM + wc * 32 + 4 * fq;
        float* base = (u.pm < 384) ? hmain : hmeta_adj;
        const float* rbase = (xp != nullptr && u.pm < 384) ? (u.pm < 256 ? xp : xs_adj) : base;
#pragma unroll
        for (int ai = 0; ai < 2; ++ai) {
            f32x4 hv[4][2][2];
#pragma unroll
            for (int m = 0; m < 4; ++m) { const float* rowp = rbase + (size_t)(row0 + ai * HALF + m * 16) * D + col0;
#pragma unroll
                for (int bj = 0; bj < 2; ++bj)
#pragma unroll
                    for (int n = 0; n < 2; ++n) hv[m][bj][n] = *(const f32x4*)(rowp + bj * HALF + n * 16); }
            asm volatile("" ::: "memory");
#pragma unroll
            for (int m = 0; m < 4; ++m) { float* rowp = base + (size_t)(row0 + ai * HALF + m * 16) * D + col0;
#pragma unroll
                for (int bj = 0; bj < 2; ++bj)
#pragma unroll
                    for (int n = 0; n < 2; ++n) *(f32x4*)(rowp + bj * HALF + n * 16) = hv[m][bj][n] + acc[ai][bj][m][n] * s; }
            asm volatile("" ::: "memory"); }
    }
};
DI void glds16s(const char* sbase, unsigned voff, unsigned ldsaddr) {
    unsigned keep; const unsigned la = (unsigned)__builtin_amdgcn_readfirstlane((int)ldsaddr);
    asm volatile("s_mov_b32 %0, m0\n\ts_mov_b32 m0, %3\n\ts_nop 0\n\tglobal_load_lds_dwordx4 %1, %2\n\ts_mov_b32 m0, %0" : "=&s"(keep) : "v"(voff), "s"(sbase), "s"(la) : "memory");
}
struct MetaOrder {
    int c;
    DI bool next(int i, Unit& u) const { if (i != 0 || c >= 8) return false; u.pm = 384 + (c >> 2); u.pn = c & 3; return true; }
};
template <class Epi, class Sched>
DI void gemm_phase(LAS unsigned char* lds, const Gemm g, const Sched& S, const Epi& E) {
    int tid_ = threadIdx.x; asm volatile("" : "+v"(tid_));
    const int tid = tid_, wid = __builtin_amdgcn_readfirstlane(tid >> 6), lane = tid & 63, wr = wid >> 2, wc = wid & 3, fr = lane & 15, fq = lane >> 4;
    const int K = g.K, lda = g.lda; int nt = K / BK; asm volatile("" : "+s"(nt));
    unsigned voffA[2], voffB[2];
#pragma unroll
    for (int i = 0; i < 2; ++i) { int R, C; stage_rc(tid * 16 + i * 8192, R, C); const int Rb = Epi::PERM ? ((R & ~31) + perm32(R & 31)) : R;
        voffA[i] = (unsigned)(R * lda + C) * 2u; voffB[i] = (unsigned)(Rb * K + C) * 2u; }
    const size_t kstep = (size_t)(BK * 2);
    const size_t hstepA = (size_t)HALF * lda * 2, hstepB = (size_t)HALF * K * 2;
    const size_t tstepA = 2 * hstepA, tstepB = 2 * hstepB;
    const unsigned ldsbase = (unsigned)(uintptr_t)lds + (unsigned)wid * 1024u;
    const int aoff = lds_byte(wr * 64 + fr, fq * 8), boff = lds_byte(wc * 32 + fr, fq * 8);
#define PG8_SA(b, h) (((b) * 2 + (h)) * HTB)
#define PG8_SB(b, h) ((4 + (b) * 2 + (h)) * HTB)
#define PG8_STAGE(bufoff, gbase, voff) do { _Pragma("unroll") for (int _i = 0; _i < 2; ++_i) \
        glds16s((const char*)(gbase), (voff)[_i], ldsbase + (unsigned)((bufoff) + _i * 8192)); } while (0)
#define PG8_LDA(dst, b, h) do { _Pragma("unroll") for (int m = 0; m < 4; ++m) _Pragma("unroll") for (int k = 0; k < 2; ++k) dst[m][k] = *(const LAS bf16x8*)(lds + PG8_SA(b, h) + aoff + m * 2048 + k * 1024); } while (0)
#define PG8_LDB(dst, b, h) do { _Pragma("unroll") for (int n = 0; n < 2; ++n) _Pragma("unroll") for (int k = 0; k < 2; ++k) dst[n][k] = *(const LAS bf16x8*)(lds + PG8_SB(b, h) + boff + n * 2048 + k * 1024); } while (0)
#define PG8_MMA(ai, bj, At, Bt) do { __builtin_amdgcn_s_setprio(1); _Pragma("unroll") for (int m = 0; m < 4; ++m) _Pragma("unroll") for (int n = 0; n < 2; ++n) _Pragma("unroll") for (int k = 0; k < 2; ++k) \
        acc[ai][bj][m][n] = __builtin_amdgcn_mfma_f32_16x16x32_bf16(Bt[n][k], At[m][k], acc[ai][bj][m][n], 0, 0, 0); __builtin_amdgcn_s_setprio(0); } while (0)
#define PG8_WAIT_V(n) asm volatile("s_waitcnt vmcnt(" #n ")" ::: "memory")
#define PG8_WAIT_L(n) asm volatile("s_waitcnt lgkmcnt(" #n ")" ::: "memory")
#define PG8_BAR __builtin_amdgcn_s_barrier()
#define PG8_SCHED __builtin_amdgcn_sched_barrier(0)
    Unit cur, nxt; int ui = 0;
    if (!S.next(0, cur)) return;
    const char* gA = (const char*)g.A; const char* gB = (const char*)g.Bt;
    asm volatile("" : "+s"(gA), "+s"(gB));
    f32x4 acc[2][2][4][2];
#pragma unroll
    for (int a = 0; a < 2; ++a)
#pragma unroll
        for (int b = 0; b < 2; ++b)
#pragma unroll
            for (int m = 0; m < 4; ++m)
#pragma unroll
                for (int n = 0; n < 2; ++n) acc[a][b][m][n] = (f32x4){0.f, 0.f, 0.f, 0.f};
    bf16x8 At[4][2], B0[2][2], B1[2][2];
    const char* cA = gA + (size_t)cur.pm * tstepA; const char* cB = gB + (size_t)cur.pn * tstepB;
    PG8_STAGE(PG8_SB(0, 0), cB, voffB); PG8_STAGE(PG8_SB(0, 1), cB + hstepB, voffB); PG8_STAGE(PG8_SA(0, 0), cA, voffA); PG8_STAGE(PG8_SA(0, 1), cA + hstepA, voffA);
    if (wr == 1) PG8_BAR;
    PG8_WAIT_V(2); PG8_BAR;
    PG8_STAGE(PG8_SB(1, 0), cB + kstep, voffB); PG8_STAGE(PG8_SA(1, 0), cA + kstep, voffA); PG8_STAGE(PG8_SB(1, 1), cB + hstepB + kstep, voffB);
    PG8_WAIT_V(6); PG8_BAR;
    for (;;) {
        const bool has_next = S.next(ui + 1, nxt);
        const char* nA = has_next ? gA + (size_t)nxt.pm * tstepA : cA; const char* nB = has_next ? gB + (size_t)nxt.pn * tstepB : cB;
        for (int t = 0; t < nt; t += 2) {
            const bool last = (t == nt - 2);
            const char* a1 = cA + (size_t)(t + 1) * kstep;
            const char* a2 = last ? nA : cA + (size_t)(t + 2) * kstep; const char* b2 = last ? nB : cB + (size_t)(t + 2) * kstep;
            const char* a3 = a2 + kstep; const char* b3 = b2 + kstep;
            PG8_LDB(B0, 0, 0); PG8_LDB(B1, 0, 1); PG8_SCHED; PG8_LDA(At, 0, 0); PG8_STAGE(PG8_SA(1, 1), a1 + hstepA, voffA);
            PG8_WAIT_V(8); PG8_WAIT_L(0); PG8_BAR; PG8_MMA(0, 0, At, B0); PG8_MMA(0, 1, At, B1); PG8_BAR; PG8_SCHED;
            PG8_LDA(At, 0, 1); PG8_STAGE(PG8_SB(0, 0), b2, voffB); PG8_STAGE(PG8_SB(0, 1), b2 + hstepB, voffB); PG8_STAGE(PG8_SA(0, 0), a2, voffA);
            PG8_WAIT_V(8); PG8_WAIT_L(0); PG8_BAR; PG8_MMA(1, 0, At, B0); PG8_MMA(1, 1, At, B1); PG8_BAR; PG8_SCHED;
            PG8_LDB(B0, 1, 0); PG8_LDB(B1, 1, 1); PG8_SCHED; PG8_LDA(At, 1, 0); PG8_STAGE(PG8_SA(0, 1), a2 + hstepA, voffA);
            PG8_WAIT_V(8); PG8_WAIT_L(0); PG8_BAR; PG8_MMA(0, 0, At, B0); PG8_MMA(0, 1, At, B1); PG8_BAR; PG8_SCHED;
            PG8_LDA(At, 1, 1); PG8_STAGE(PG8_SB(1, 0), b3, voffB); PG8_STAGE(PG8_SB(1, 1), b3 + hstepB, voffB); PG8_STAGE(PG8_SA(1, 0), a3, voffA);
            PG8_WAIT_V(8); PG8_WAIT_L(0); PG8_BAR; PG8_MMA(1, 0, At, B0); PG8_MMA(1, 1, At, B1); PG8_BAR; PG8_SCHED;
        }
        if (wr == 0) PG8_BAR;
        E(acc, cur, wr, wc, fr, fq);
        if (!has_next) break;
#pragma unroll
        for (int a = 0; a < 2; ++a)
#pragma unroll
            for (int b = 0; b < 2; ++b)
#pragma unroll
                for (int m = 0; m < 4; ++m)
#pragma unroll
                    for (int n = 0; n < 2; ++n) acc[a][b][m][n] = (f32x4){0.f, 0.f, 0.f, 0.f};
        cur = nxt; cA = nA; cB = nB; ++ui;
        if (wr == 1) PG8_BAR;
    }
    PG8_WAIT_V(0);
    PG8_BAR;
#undef PG8_SA
#undef PG8_SB
#undef PG8_STAGE
#undef PG8_LDA
#undef PG8_LDB
#undef PG8_MMA
#undef PG8_WAIT_V
#undef PG8_WAIT_L
#undef PG8_BAR
#undef PG8_SCHED
}
}

struct Params { const float* in[17]; float* out; unsigned char* ws; };

DI float* hrow(const Params& p, int r) { return r < NREAL ? p.out + (size_t)r * D : (float*)(p.ws + WS_HMETA) + (size_t)(r - NREAL) * D; }

DI void transpose_item(const float* W, int N, bf16_t* WT, int ldt, int koff, int k0, int n0, int drow0, LAS float* scr, int lane) {
#pragma unroll 8
    for (int i = 0; i < 32; ++i) { const int kk = 2 * i + (lane >> 5); scr[kk * 33 + (lane & 31)] = W[(size_t)(k0 + kk) * N + n0 + (lane & 31)]; }
    asm volatile("s_waitcnt lgkmcnt(0)" ::: "memory");
    const int c = lane & 7;
#pragma unroll
    for (int j = 0; j < 4; ++j) { const int n = (lane >> 3) + 8 * j; const LAS float* s = scr + (8 * c) * 33 + n;
        u32x4 o; o.x = cvtpk(s[0 * 33], s[1 * 33]); o.y = cvtpk(s[2 * 33], s[3 * 33]); o.z = cvtpk(s[4 * 33], s[5 * 33]); o.w = cvtpk(s[6 * 33], s[7 * 33]);
        *(u32x4*)(WT + (size_t)(drow0 + n) * ldt + koff + k0 + 8 * c) = o; }
    asm volatile("s_waitcnt lgkmcnt(0)" ::: "memory");
}

DI void prologue(const Params& p, LAS unsigned char* lds, int gw_, int NGW, int wave_, int lane_) {
    const int tid = opaque_tid(), lane = tid & 63, wave = __builtin_amdgcn_readfirstlane(tid >> 6), gw = blockIdx.x * 8 + wave;
    LAS float* scr = (LAS float*)(lds + wave * 16384);
    unsigned char* ws = p.ws;
    constexpr int I_G = 16 * 88, I_D = 44 * 32, I_IN = 16 * 85, I_O = 16 * 32, I_UQ = 4 * 12, I_UKV = 2 * 16;
    constexpr int T_G = 4 * I_G, T_U = 4 * I_G, T_D = 4 * I_D, T_IN = 2 * I_IN, T_O = 2 * I_O, T_UQ = 2 * I_UQ, T_UKV = 2 * I_UKV;
    constexpr int NITEMS = T_G + T_U + T_D + T_IN + T_O + T_UQ + T_UKV;
    for (int it = gw; it < NITEMS; it += NGW) {
        int r = it;
        if (r < T_G + T_U) { const bool up = r >= T_G; if (up) r -= T_G; const int mi = r / I_G, q = r % I_G, kb = q / 88, nb = q % 88, n0 = nb * 32;
            const float* W = p.in[up ? 6 : 5] + (size_t)mi * 1024 * 2816; bf16_t* WT = (bf16_t*)(ws + WS_WGU) + (size_t)mi * 5632 * 1024;
            transpose_item(W, 2816, WT, 1024, 0, kb * 64, n0, (n0 / 128) * 256 + (n0 % 128) + (up ? 128 : 0), scr, lane); continue; }
        r -= T_G + T_U;
        if (r < T_D) { const int mi = r / I_D, q = r % I_D, kb = q / 32, nb = q % 32;
            transpose_item(p.in[7] + (size_t)mi * 2816 * 1024, 1024, (bf16_t*)(ws + WS_WDN) + (size_t)mi * 1024 * 2816, 2816, 0, kb * 64, nb * 32, nb * 32, scr, lane); continue; }
        r -= T_D;
        if (r < T_IN) { const int mi = r / I_IN, q = r % I_IN, kb = q / 85, nb = q % 85;
            transpose_item(p.in[8] + (size_t)mi * 1024 * 2720, 2720, (bf16_t*)(ws + WS_WIN) + (size_t)mi * 2816 * 1024, 1024, 0, kb * 64, nb * 32, nb * 32, scr, lane); continue; }
        r -= T_IN;
        if (r < T_O) { const int mi = r / I_O, q = r % I_O, kb = q / 32, nb = q % 32;
            transpose_item(p.in[9] + (size_t)mi * 1024 * 1024, 1024, (bf16_t*)(ws + WS_WOUT) + (size_t)mi * 1024 * 1024, 1024, 0, kb * 64, nb * 32, nb * 32, scr, lane); continue; }
        r -= T_O;
        if (r < T_UQ) { const int mi = r / I_UQ, q = r % I_UQ, kb = q / 12, nb = q % 12;
            transpose_item(p.in[15] + (size_t)mi * 256 * 384, 384, (bf16_t*)(ws + WS_WMLA) + (size_t)mi * 1024 * 384, 384, 0, kb * 64, nb * 32, nb * 32, scr, lane); continue; }
        r -= T_UQ;
        { const int mi = r / I_UKV, q = r % I_UKV, kb = q / 16, nb = q % 16;
            transpose_item(p.in[16] + (size_t)mi * 128 * 512, 512, (bf16_t*)(ws + WS_WMLA) + (size_t)mi * 1024 * 384, 384, 256, kb * 64, nb * 32, 512 + nb * 32, scr, lane); }
    }
    const int gt = gw * 64 + lane, NGT = NGW * 64;
    for (int i = gt; i < 2 * 96 * 128; i += NGT) { const int mi = i / (96 * 128), q = i % (96 * 128), row = 2720 + q / 128, ch = q % 128;
        *(u32x4*)((bf16_t*)(ws + WS_WIN) + (size_t)mi * 2816 * 1024 + (size_t)row * 1024 + ch * 8) = (u32x4){0u, 0u, 0u, 0u}; }
    for (int i = gt; i < 2 * 1024 * 48; i += NGT) { const int mi = i / (1024 * 48), q = i % (1024 * 48), row = q / 48, ch = q % 48;
        const bool z = row < 384 ? (ch >= 32) : (row < 512 ? true : (ch < 32));
        if (z) *(u32x4*)((bf16_t*)(ws + WS_WMLA) + (size_t)mi * 1024 * 384 + (size_t)row * 384 + ch * 8) = (u32x4){0u, 0u, 0u, 0u}; }
    const float L2T = 18.931568569324174f;
    for (int i = gt; i < 8208 * 16; i += NGT) { const int pos = i >> 4, f = i & 15; const float inv = exp2f(-(float)f * (1.0f / 16.0f) * L2T);
        const double rev = (double)pos * (double)inv * 0.15915494309189535; const float fr = (float)(rev - floor(rev));
        ((float*)(ws + WS_TABM))[i] = __builtin_amdgcn_cosf(fr); ((float*)(ws + WS_TABM))[8208 * 16 + i] = __builtin_amdgcn_sinf(fr); }
    for (int i = gt; i < 8208 * 4; i += NGT) { const int pos = i >> 2, f = i & 3; const float inv = exp2f(-(float)f * 0.25f * L2T);
        const double rev = (double)pos * (double)inv * 0.15915494309189535; const float fr = (float)(rev - floor(rev));
        ((float*)(ws + WS_TABD))[i] = __builtin_amdgcn_cosf(fr); ((float*)(ws + WS_TABD))[8208 * 4 + i] = __builtin_amdgcn_sinf(fr); }
    if (gw < 2) { const float* lp = p.in[11] + gw * 128; float a = lane < 32 ? lp[lane] * lp[32 + lane] : 0.f, b = lane < 32 ? lp[64 + lane] * lp[96 + lane] : 0.f;
        a = wave_sum(a); b = wave_sum(b); const float li = 0.8f - 0.6f * expf(-0.3f * (float)gw);
        if (lane == 0) { ((float*)(ws + WS_CTL))[8192 + gw] = expf(a) - expf(b) + li; ((float*)(ws + WS_CTL))[8194 + gw] = li; } }
}

template <int MODE>
DI void norm_rows(const Params& p, const float* g, int gw_, int NGW, int lane_, int r_lo = 0, int r_hi = MP, int wg_lo = 0) {
    const int tid = opaque_tid(), lane = tid & 63, gw = ((int)blockIdx.x - wg_lo) * 8 + __builtin_amdgcn_readfirstlane(tid >> 6);
    bf16_t* XO = (bf16_t*)(p.ws + WS_XO);
    f32x4 gv[4];
#pragma unroll
    for (int j = 0; j < 4; ++j) gv[j] = *(const f32x4*)(g + 4 * lane + 256 * j);
    for (int r0 = r_lo + gw * 4; r0 < r_hi; r0 += NGW * 4) {
        if (r0 >= MR) {
#pragma unroll
            for (int q = 0; q < 4; ++q) { u32x2* o = (u32x2*)(XO + (size_t)(r0 + q) * D) + lane;
#pragma unroll
                for (int j = 0; j < 4; ++j) o[64 * j] = (u32x2){0u, 0u}; }
            continue; }
        f32x4 v[4][4]; float s[4];
#pragma unroll
        for (int q = 0; q < 4; ++q) { const int r = r0 + q;
            const float* src = hrow(p, r);
            if (MODE == 1) src = r < 65536 ? p.in[0] + (size_t)r * D : (r < NREAL ? p.in[1] + (size_t)(r - 65536) * D : p.in[2] + (size_t)((r - NREAL) & 15) * D);
#pragma unroll
            for (int j = 0; j < 4; ++j) v[q][j] = __builtin_nontemporal_load((const f32x4*)(src + 4 * lane + 256 * j)); }
#pragma unroll
        for (int q = 0; q < 4; ++q) { float a = 0.f;
#pragma unroll
            for (int j = 0; j < 4; ++j) a += (v[q][j].x * v[q][j].x + v[q][j].y * v[q][j].y) + (v[q][j].z * v[q][j].z + v[q][j].w * v[q][j].w);
            s[q] = a; }
        if (MODE == 1 && r0 >= NREAL) {
#pragma unroll
            for (int q = 0; q < 4; ++q) { float* hd = hrow(p, r0 + q);
#pragma unroll
                for (int j = 0; j < 4; ++j) *(f32x4*)(hd + 4 * lane + 256 * j) = v[q][j]; } }
#pragma unroll
        for (int o_ = 1; o_ < 64; o_ <<= 1) {
#pragma unroll
            for (int q = 0; q < 4; ++q) s[q] += __shfl_xor(s[q], o_); }
#pragma unroll
        for (int q = 0; q < 4; ++q) { const float rstd = 1.0f / sqrtf(s[q] * (1.0f / D) + EPS); u32x2* o = (u32x2*)(XO + (size_t)(r0 + q) * D) + lane;
#pragma unroll
            for (int j = 0; j < 4; ++j) { const f32x4 y = v[q][j] * rstd * gv[j]; o[64 * j] = (u32x2){cvtpk(y.x, y.y), cvtpk(y.z, y.w)}; } }
    }
}
DI void final_rows(const Params& p, int gw_, int NGW, int lane_) {
    const int tid = opaque_tid(), lane = tid & 63, gw = blockIdx.x * 8 + __builtin_amdgcn_readfirstlane(tid >> 6);
    const float* g = p.in[4];
    f32x4 gv[4];
#pragma unroll
    for (int j = 0; j < 4; ++j) gv[j] = *(const f32x4*)(g + 4 * lane + 256 * j);
    for (int r0 = gw * 4; r0 < NREAL; r0 += NGW * 4) {
        f32x4 v[4][4]; float s[4];
#pragma unroll
        for (int q = 0; q < 4; ++q) { const float* hd = p.out + (size_t)(r0 + q) * D;
#pragma unroll
            for (int j = 0; j < 4; ++j) v[q][j] = *(const f32x4*)(hd + 4 * lane + 256 * j); }
#pragma unroll
        for (int q = 0; q < 4; ++q) { float a = 0.f;
#pragma unroll
            for (int j = 0; j < 4; ++j) a += (v[q][j].x * v[q][j].x + v[q][j].y * v[q][j].y) + (v[q][j].z * v[q][j].z + v[q][j].w * v[q][j].w);
            s[q] = a; }
#pragma unroll
        for (int o_ = 1; o_ < 64; o_ <<= 1) {
#pragma unroll
            for (int q = 0; q < 4; ++q) s[q] += __shfl_xor(s[q], o_); }
#pragma unroll
        for (int q = 0; q < 4; ++q) { const float rstd = 1.0f / sqrtf(s[q] * (1.0f / D) + EPS); float* hd = p.out + (size_t)(r0 + q) * D;
#pragma unroll
            for (int j = 0; j < 4; ++j) __builtin_nontemporal_store(v[q][j] * rstd * gv[j], (f32x4*)(hd + 4 * lane + 256 * j)); }
    }
}
DI void prep_rows(const Params& p, int layer, int gw_, int NGW, int lane_) {
    const int tid = opaque_tid(), lane = tid & 63, gw = blockIdx.x * 8 + __builtin_amdgcn_readfirstlane(tid >> 6);
    bf16_t* U = (bf16_t*)(p.ws + WS_BIG);
    const float* gq = p.in[13] + layer * 256; const float* gkv = p.in[14] + layer * 128;
    const float* tmc = (const float*)(p.ws + WS_TABM); const float* tms = tmc + 8208 * 16;
    const float* tdc = (const float*)(p.ws + WS_TABD); const float* tds = tdc + 8208 * 4;
    const f32x4 gqv = *(const f32x4*)(gq + 4 * lane); const f32x2 gkvv = *(const f32x2*)(gkv + 2 * lane);
    for (int r0 = gw * 4; r0 < MR; r0 += NGW * 4) {
        u32x2 wq[4]; unsigned wk[4], d1[4], d2[4]; f32x2 dc[4], ds[4]; float k1[4], k2[4], kc[4], ks[4];
#pragma unroll
        for (int q = 0; q < 4; ++q) { bf16_t* ur = U + (size_t)(r0 + q) * INP; const int pos = row_pos(r0 + q);
            wq[q] = *(const u32x2*)(ur + U_CQ + 4 * lane); wk[q] = *(const unsigned*)(ur + U_CKV + 2 * lane);
            if (lane < 48) { const bf16_t* cp = ur + U_DAQ + 32 * (lane >> 1) + 2 * (lane & 1); d1[q] = *(const unsigned*)cp; d2[q] = *(const unsigned*)(cp + 4);
                dc[q] = *(const f32x2*)(tdc + pos * 4 + 2 * (lane & 1)); ds[q] = *(const f32x2*)(tds + pos * 4 + 2 * (lane & 1)); }
            else { const int i = lane - 48; const bf16_t* cp = ur + U_KR + i; k1[q] = bf2f(cp[0]); k2[q] = bf2f(cp[16]); kc[q] = tmc[pos * 16 + i]; ks[q] = tms[pos * 16 + i]; } }
        float sq[4], sk[4]; float a[4][4], b[4][2];
#pragma unroll
        for (int q = 0; q < 4; ++q) {
            a[q][0] = __uint_as_float(wq[q].x << 16); a[q][1] = __uint_as_float(wq[q].x & 0xffff0000u); a[q][2] = __uint_as_float(wq[q].y << 16); a[q][3] = __uint_as_float(wq[q].y & 0xffff0000u);
            b[q][0] = __uint_as_float(wk[q] << 16); b[q][1] = __uint_as_float(wk[q] & 0xffff0000u);
            sq[q] = (a[q][0] * a[q][0] + a[q][1] * a[q][1]) + (a[q][2] * a[q][2] + a[q][3] * a[q][3]); sk[q] = b[q][0] * b[q][0] + b[q][1] * b[q][1]; }
#pragma unroll
        for (int o_ = 1; o_ < 64; o_ <<= 1) {
#pragma unroll
            for (int q = 0; q < 4; ++q) { sq[q] += __shfl_xor(sq[q], o_); sk[q] += __shfl_xor(sk[q], o_); } }
#pragma unroll
        for (int q = 0; q < 4; ++q) { bf16_t* ur = U + (size_t)(r0 + q) * INP;
            const float rq = 1.0f / sqrtf(sq[q] * (1.0f / 256.0f) + EPS), rk = 1.0f / sqrtf(sk[q] * (1.0f / 128.0f) + EPS);
            *(u32x2*)(ur + U_CQ + 4 * lane) = (u32x2){cvtpk(a[q][0] * rq * gqv.x, a[q][1] * rq * gqv.y), cvtpk(a[q][2] * rq * gqv.z, a[q][3] * rq * gqv.w)};
            *(unsigned*)(ur + U_CKV + 2 * lane) = cvtpk(b[q][0] * rk * gkvv.x, b[q][1] * rk * gkvv.y);
            if (lane < 48) {
                bf16_t* cp = ur + U_DAQ + 32 * (lane >> 1) + 2 * (lane & 1);
                const float x1a = __uint_as_float(d1[q] << 16), x1b = __uint_as_float(d1[q] & 0xffff0000u), x2a = __uint_as_float(d2[q] << 16), x2b = __uint_as_float(d2[q] & 0xffff0000u);
                *(unsigned*)cp = cvtpk(x1a * dc[q].x - x2a * ds[q].x, x1b * dc[q].y - x2b * ds[q].y);
                *(unsigned*)(cp + 4) = cvtpk(x2a * dc[q].x + x1a * ds[q].x, x2b * dc[q].y + x1b * ds[q].y);
            } else {
                bf16_t* cp = ur + U_KR + (lane - 48);
                const unsigned y = cvtpk(k1[q] * kc[q] - k2[q] * ks[q], k2[q] * kc[q] + k1[q] * ks[q]);
                cp[0] = (bf16_t)(y & 0xffffu); cp[16] = (bf16_t)(y >> 16);
            } }
    }
}

DI float max3f(float a, float b, float c) { float r; asm("v_max3_f32 %0, %1, %2, %3" : "=v"(r) : "v"(a), "v"(b), "v"(c)); return r; }
DI float max2f(float a, float b) { float r; asm("v_max_f32_e32 %0, %1, %2" : "=v"(r) : "v"(a), "v"(b)); return r; }
DI int crow(int r, int hi) { return (r & 3) + 8 * (r >> 2) + 4 * hi; }
DI s16x4 vtr(const LAS unsigned char* p) { typedef short v4i16_t __attribute__((ext_vector_type(4))); return __builtin_bit_cast(s16x4, __builtin_amdgcn_ds_read_tr16_b64_v4i16((LAS v4i16_t*)p)); }

constexpr int FL_STG = 20480, FL_KR = 8192, FL_V = 12288, FL_NST = 3;
constexpr int NA_BIAS_OFF = 131072 + 1024, NA_V_OFF = 65536, NA_V_WAVE = 32 * 192;

template <int NC, int DQK>
DI void flash_unit(LAS unsigned char* lds, const Params& p, int layer, int seq, int h, int qb) {
    constexpr int NS = DQK / 16;
    const bf16_t* U = (const bf16_t*)(p.ws + WS_BIG); const bf16_t* QM = (const bf16_t*)(p.ws + WS_QKVM); bf16_t* XO = (bf16_t*)(p.ws + WS_XO);
    const int tid = opaque_tid(), lane = tid & 63, r32 = lane & 31, hi = lane >> 5, wid = __builtin_amdgcn_readfirstlane(tid >> 6);
    const int Treal = seq < 8 ? 8192 : 2048, rbase = seq < 8 ? seq * 8192 : 65536 + (seq - 8) * 2048, mbase = METAB + 16 * seq;
    const int nqb = Treal / 256, NT = Treal / 64 + 1;
    const bool metaq = (qb >= nqb);
    const int qrow = metaq ? mbase + (r32 & 15) : rbase + 256 * qb + 32 * wid + r32;
    const bool valid = metaq ? (wid == 0 && r32 < 16) : true;
    bf16x8 qf[NC][NS];
#pragma unroll
    for (int c = 0; c < NC; ++c)
#pragma unroll
        for (int s = 0; s < NS; ++s) {
            const bf16_t* src = (NC == 2) ? U + (size_t)qrow * INP + U_DAQ + 64 * h + c * DQK + 16 * s + 8 * hi : QM + (size_t)qrow * 1024 + 96 * h + 16 * s + 8 * hi;
            qf[c][s] = *(const bf16x8*)src; }
    if (NC == 1) {
        const float* tc = (const float*)(p.ws + WS_TABM) + row_pos(qrow) * 16 + 8 * hi; const float* tsn = tc + 8208 * 16;
        const f32x4 c0 = *(const f32x4*)tc, c1 = *(const f32x4*)(tc + 4), s0 = *(const f32x4*)tsn, s1 = *(const f32x4*)(tsn + 4);
        const u32x4 a = __builtin_bit_cast(u32x4, qf[0][NS - 2]), b = __builtin_bit_cast(u32x4, qf[0][NS - 1]); u32x4 ra, rb;
#pragma unroll
        for (int w = 0; w < 4; ++w) { const float cl = w < 2 ? c0[2 * w] : c1[2 * w - 4], ch = w < 2 ? c0[2 * w + 1] : c1[2 * w - 3], sl = w < 2 ? s0[2 * w] : s1[2 * w - 4], sh = w < 2 ? s0[2 * w + 1] : s1[2 * w - 3];
            const float x1l = __uint_as_float(a[w] << 16), x1h = __uint_as_float(a[w] & 0xffff0000u), x2l = __uint_as_float(b[w] << 16), x2h = __uint_as_float(b[w] & 0xffff0000u);
            ra[w] = cvtpk(x1l * cl - x2l * sl, x1h * ch - x2h * sh); rb[w] = cvtpk(x2l * cl + x1l * sl, x2h * ch + x1h * sh); }
        qf[0][NS - 2] = __builtin_bit_cast(bf16x8, ra); qf[0][NS - 1] = __builtin_bit_cast(bf16x8, rb);
    }
    const float sc = (NC == 2 ? 0.17677669529663687f : 0.10206207261596575f) * 1.4426950408889634f;
#pragma unroll
    for (int c = 0; c < NC; ++c)
#pragma unroll
        for (int s = 0; s < NS; ++s) { const u32x4 a = __builtin_bit_cast(u32x4, qf[c][s]); u32x4 ra;
#pragma unroll
            for (int w = 0; w < 4; ++w) ra[w] = cvtpk(__uint_as_float(a[w] << 16) * sc, __uint_as_float(a[w] & 0xffff0000u) * sc);
            qf[c][s] = __builtin_bit_cast(bf16x8, ra); }
    const unsigned ldsb = (unsigned)(uintptr_t)lds;
    const int drow = 8 * wid + (lane >> 3), dcp = lane & 7;
    const int KPITCH = (NC == 2) ? INP * 2 : 2048;
    const unsigned kvoff = (unsigned)(drow * KPITCH + ((dcp ^ ((drow >> 1) & 7)) * 16));
    const unsigned vvoff = (unsigned)(drow * KPITCH + ((dcp ^ (((drow >> 1) & 1) << 2)) * 16));
    const int rrow = 8 * wid + ((lane & 31) >> 2), rcp = lane & 3;
    const unsigned rvoff = (unsigned)(rrow * (INP * 2) + ((rcp ^ ((rrow >> 2) & 3)) * 16));
    const char* kbase0 = (NC == 2) ? (const char*)(U + U_DAK + 64 * h) : (const char*)(QM + 512 + 128 * h);
    const char* vbase0 = (NC == 2) ? (const char*)(U + U_DAV + 64 * h) : (const char*)(QM + 512 + 128 * h + 64);
    const char* rbase0 = (const char*)(U + U_KR);
    auto dma_tile = [&](int t, int slot) {
        const int tt = t < NT ? t : NT - 1;
        const size_t kr = (size_t)(tt == 0 ? mbase : rbase + 64 * (tt - 1));
        const unsigned dst = ldsb + (unsigned)(slot * FL_STG) + (unsigned)wid * 1024u;
        pg8::glds16s(kbase0 + kr * KPITCH, kvoff, dst);
        pg8::glds16s(vbase0 + kr * KPITCH, vvoff, dst + FL_V);
        if (NC == 1) { if (lane < 32) pg8::glds16s(rbase0 + kr * (INP * 2), rvoff, ldsb + (unsigned)(slot * FL_STG) + FL_KR + (unsigned)wid * 512u); }
    };
    float mrun[NC], lrun[NC]; f32x16 o[NC][2];
    f32x16 negm[NC];
#pragma unroll
    for (int c = 0; c < NC; ++c) { mrun[c] = 0.f; lrun[c] = 0.f;
#pragma unroll
        for (int r = 0; r < 16; ++r) negm[c][r] = 0.f;
#pragma unroll
        for (int c2 = 0; c2 < 2; ++c2)
#pragma unroll
            for (int r = 0; r < 16; ++r) o[c][c2][r] = 0.f; }
    dma_tile(0, 0); dma_tile(1, 1);
    const int ksw = (r32 >> 1) & 7;
    int koffs[NC * 2 > 4 ? NC * 2 : 4];
#pragma unroll
    for (int i = 0; i < 4; ++i) koffs[i] = r32 * 128 + (((2 * i + hi) ^ ksw) * 16);
    const int rsw = (r32 >> 2) & 3;
    int roffs[2];
#pragma unroll
    for (int i = 0; i < 2; ++i) roffs[i] = FL_KR + r32 * 64 + (((2 * i + hi) ^ rsw) * 16);
    const int vq = (lane & 15) >> 2, vp = lane & 3, vblk = (lane >> 4) & 1;
    int voffs[2];
#pragma unroll
    for (int c2 = 0; c2 < 2; ++c2) voffs[c2] = FL_V + (4 * hi + vq) * 128 + ((c2 ^ ((vq >> 1) & 1)) * 64) + (2 * vblk + (vp >> 1)) * 16 + 8 * (vp & 1);
    int slot = 0;
    for (int t = 0; t < NT; ++t) {
        if (NC == 2) asm volatile("s_waitcnt vmcnt(2)\n\ts_barrier" ::: "memory"); else asm volatile("s_waitcnt vmcnt(3)\n\ts_barrier" ::: "memory");
        { int s2 = slot + 2; if (s2 >= FL_NST) s2 -= FL_NST; dma_tile(t + 2, s2); }
        const LAS unsigned char* kb = lds + slot * FL_STG;
        const LAS unsigned char* vb = kb;
        slot = (slot + 1 == FL_NST) ? 0 : slot + 1;
        bf16x8 pb[NC][2][2];
        bf16x8 vf[2][2][2];
#pragma unroll
        for (int c = 0; c < NC; ++c) {
            bf16x8 ka[NS][2];
#pragma unroll
            for (int s = 0; s < NS; ++s) {
                const int ko = (NC == 2) ? koffs[2 * c + s] : (s < 4 ? koffs[s < 4 ? s : 0] : roffs[s >= 4 ? s - 4 : 0]);
                const int kstep32 = (NC == 1 && s >= 4) ? 32 * 64 : 32 * 128;
                ka[s][0] = *(const LAS bf16x8*)(kb + ko);
                ka[s][1] = *(const LAS bf16x8*)(kb + ko + kstep32); }
            __builtin_amdgcn_sched_barrier(0);
            f32x16 s0 = negm[c], s1 = negm[c];
#pragma unroll
            for (int s = 0; s < NS; ++s) {
                s0 = __builtin_amdgcn_mfma_f32_32x32x16_bf16(ka[s][0], qf[c][s], s0, 0, 0, 0);
                s1 = __builtin_amdgcn_mfma_f32_32x32x16_bf16(ka[s][1], qf[c][s], s1, 0, 0, 0); }
            if (NC == 1) {
#pragma unroll
                for (int c2 = 0; c2 < 2; ++c2)
#pragma unroll
                    for (int kh = 0; kh < 2; ++kh)
#pragma unroll
                        for (int s2 = 0; s2 < 2; ++s2) {
                            const LAS unsigned char* vp = vb + voffs[c2] + (32 * kh + 16 * s2) * 128;
                            const s16x4 lo = vtr(vp), hh = vtr(vp + 8 * 128);
                            vf[c2][kh][s2] = (bf16x8){lo[0], lo[1], lo[2], lo[3], hh[0], hh[1], hh[2], hh[3]}; }
            }
            __builtin_amdgcn_sched_barrier(0);
            asm volatile("s_nop 15\n\ts_nop 7" : "+v"(s0), "+v"(s1));
            if (t == 0) {
#pragma unroll
                for (int r = 0; r < 16; ++r) { if (r >= 8) s0[r] = -INFINITY; s1[r] = -INFINITY; } }
            float ra = max3f(s0[0], s0[1], s1[0]), rb = max3f(s0[2], s0[3], s1[1]); ra = max3f(ra, s1[2], s1[3]);
#pragma unroll
            for (int r = 4; r < 16; r += 4) { ra = max3f(ra, s0[r], s0[r + 1]); rb = max3f(rb, s0[r + 2], s0[r + 3]); ra = max3f(ra, s1[r], s1[r + 1]); rb = max3f(rb, s1[r + 2], s1[r + 3]); }
            float rm = max2f(ra, rb);
            { auto rr = __builtin_amdgcn_permlane32_swap(__float_as_uint(rm), __float_as_uint(rm), false, false); rm = max2f(__uint_as_float(rr[0]), __uint_as_float(rr[1])); }
            if (t == 0 || __any(rm > 8.0f)) {
                const float delta = (t == 0) ? rm : max2f(rm, 0.f);
                const float alpha = (t == 0) ? 1.0f : __builtin_amdgcn_exp2f(-delta);
                mrun[c] += delta; lrun[c] *= alpha;
#pragma unroll
                for (int c2 = 0; c2 < 2; ++c2)
#pragma unroll
                    for (int r = 0; r < 16; ++r) o[c][c2][r] *= alpha;
#pragma unroll
                for (int r = 0; r < 16; ++r) { s0[r] -= delta; s1[r] -= delta; negm[c][r] = -mrun[c]; } }
#pragma unroll
            for (int r = 0; r < 16; ++r) { s0[r] = __builtin_amdgcn_exp2f(s0[r]); s1[r] = __builtin_amdgcn_exp2f(s1[r]); }
            f32x2 la = {0.f, 0.f}, lb = {0.f, 0.f};
#pragma unroll
            for (int r = 0; r < 16; r += 2) { la += (f32x2){s0[r], s0[r + 1]}; lb += (f32x2){s1[r], s1[r + 1]}; }
            la += lb; lrun[c] += la.x + la.y;
#pragma unroll
            for (int s2 = 0; s2 < 2; ++s2) {
                u32x4 w0, w1;
                w0.x = cvtpk(s0[8 * s2 + 0], s0[8 * s2 + 1]); w0.y = cvtpk(s0[8 * s2 + 2], s0[8 * s2 + 3]); w0.z = cvtpk(s0[8 * s2 + 4], s0[8 * s2 + 5]); w0.w = cvtpk(s0[8 * s2 + 6], s0[8 * s2 + 7]);
                w1.x = cvtpk(s1[8 * s2 + 0], s1[8 * s2 + 1]); w1.y = cvtpk(s1[8 * s2 + 2], s1[8 * s2 + 3]); w1.z = cvtpk(s1[8 * s2 + 4], s1[8 * s2 + 5]); w1.w = cvtpk(s1[8 * s2 + 6], s1[8 * s2 + 7]);
                pb[c][0][s2] = __builtin_bit_cast(bf16x8, w0); pb[c][1][s2] = __builtin_bit_cast(bf16x8, w1); }
        }
#pragma unroll
        for (int kh = 0; kh < 2; ++kh)
#pragma unroll
            for (int s2 = 0; s2 < 2; ++s2)
#pragma unroll
                for (int c2 = 0; c2 < 2; ++c2) {
                    bf16x8 va;
                    if (NC == 1) va = vf[c2][kh][s2];
                    else { const LAS unsigned char* vp = vb + voffs[c2] + (32 * kh + 16 * s2) * 128;
                        const s16x4 lo = vtr(vp), hh = vtr(vp + 8 * 128);
                        va = (bf16x8){lo[0], lo[1], lo[2], lo[3], hh[0], hh[1], hh[2], hh[3]}; }
#pragma unroll
                    for (int c = 0; c < NC; ++c) o[c][c2] = __builtin_amdgcn_mfma_f32_32x32x16_bf16(va, pb[c][kh][s2], o[c][c2], 0, 0, 0);
                }
    }
    asm volatile("s_waitcnt vmcnt(0)" ::: "memory");
    float inv[NC];
#pragma unroll
    for (int c = 0; c < NC; ++c) inv[c] = 1.0f / swapsum(lrun[c]);
    if (NC == 2) {
        const float lam = ((const float*)(p.ws + WS_CTL))[8192 + layer], li = ((const float*)(p.ws + WS_CTL))[8194 + layer];
        float ss = 0.f;
#pragma unroll
        for (int c2 = 0; c2 < 2; ++c2)
#pragma unroll
            for (int r = 0; r < 16; ++r) { const float v = o[0][c2][r] * inv[0] - lam * (o[NC - 1][c2][r] * inv[NC - 1]); o[0][c2][r] = v; ss += v * v; }
        ss = swapsum(ss);
        const float rs = (1.0f - li) / sqrtf(ss * (1.0f / 64.0f) + EPS);
        const float* sg = p.in[12] + layer * 64;
        bf16_t* dst = XO + (size_t)qrow * 1024 + 384 + 64 * h;
        if (valid) {
#pragma unroll
            for (int c2 = 0; c2 < 2; ++c2)
#pragma unroll
                for (int g4 = 0; g4 < 4; ++g4) { const int dv0 = 32 * c2 + 8 * g4 + 4 * hi; const f32x4 gg = *(const f32x4*)(sg + dv0);
                    *(u32x2*)(dst + dv0) = (u32x2){cvtpk(o[0][c2][4 * g4] * rs * gg.x, o[0][c2][4 * g4 + 1] * rs * gg.y), cvtpk(o[0][c2][4 * g4 + 2] * rs * gg.z, o[0][c2][4 * g4 + 3] * rs * gg.w)}; }
        }
    } else {
        bf16_t* dst = XO + (size_t)qrow * 1024 + 768 + 64 * h;
        if (valid) {
#pragma unroll
            for (int c2 = 0; c2 < 2; ++c2)
#pragma unroll
                for (int g4 = 0; g4 < 4; ++g4) { const int dv0 = 32 * c2 + 8 * g4 + 4 * hi; const float iv = inv[0];
                    *(u32x2*)(dst + dv0) = (u32x2){cvtpk(o[0][c2][4 * g4] * iv, o[0][c2][4 * g4 + 1] * iv), cvtpk(o[0][c2][4 * g4 + 2] * iv, o[0][c2][4 * g4 + 3] * iv)}; }
        }
    }
}

DI void na_task(LAS unsigned char* wv, const LAS float* btab, const Params& p, int seq, int r, int rows, int cb, int h, bool metaq) {
    const bf16_t* U = (const bf16_t*)(p.ws + WS_BIG); bf16_t* XO = (bf16_t*)(p.ws + WS_XO);
    const int lane = opaque_tid() & 63, m16 = lane & 15, kg = lane >> 4;
    const int rbase = seq < 8 ? seq * 8192 : 65536 + (seq - 8) * 2048, mbase = METAB + 16 * seq;
    const int qrow = metaq ? mbase + m16 : rbase + r * 64 + 16 * cb + m16;
    bf16x8 qf[2];
#pragma unroll
    for (int s = 0; s < 2; ++s) qf[s] = *(const bf16x8*)(U + (size_t)qrow * INP + U_NAQ + 64 * h + 32 * s + 8 * kg);
    int rs = r - 4; rs = rs < 0 ? 0 : (rs > rows - 8 ? rows - 8 : rs);
    const int kc0 = cb == 0 ? 0 : (cb == 1 ? 8 : (cb == 2 ? 24 : 32));
    const int qc = 16 * cb + m16; int wsq = qc - 8; wsq = wsq < 0 ? 0 : (wsq > 48 ? 48 : wsq);
    f32x4 sc[17];
    const f32x4 z4 = {0.f, 0.f, 0.f, 0.f};
    { const bf16_t* kp = U + (size_t)(mbase + m16) * INP + U_NAK + 64 * h + 8 * kg;
      f32x4 a = __builtin_amdgcn_mfma_f32_16x16x32_bf16(*(const bf16x8*)kp, qf[0], z4, 0, 0, 0);
      a = __builtin_amdgcn_mfma_f32_16x16x32_bf16(*(const bf16x8*)(kp + 32), qf[1], a, 0, 0, 0);
      sc[16] = a * 0.125f; }
#pragma unroll
    for (int i = 0; i < 16; ++i) sc[i] = (f32x4){-INFINITY, -INFINITY, -INFINITY, -INFINITY};
    if (!metaq) {
#pragma unroll
        for (int w = 0; w < 8; ++w)
#pragma unroll
            for (int hf = 0; hf < 2; ++hf) {
                const bf16_t* kp = U + (size_t)(rbase + (rs + w) * 64 + kc0 + 16 * hf + m16) * INP + U_NAK + 64 * h + 8 * kg;
                f32x4 a = __builtin_amdgcn_mfma_f32_16x16x32_bf16(*(const bf16x8*)kp, qf[0], z4, 0, 0, 0);
                a = __builtin_amdgcn_mfma_f32_16x16x32_bf16(*(const bf16x8*)(kp + 32), qf[1], a, 0, 0, 0);
                const LAS float* brow = btab + h * 465 + (rs + w - r + 7) * 31;
#pragma unroll
                for (int j = 0; j < 4; ++j) { const int kc = kc0 + 16 * hf + 4 * kg + j; const bool ok = (kc >= wsq) && (kc < wsq + 16);
                    int bi = kc - qc + 15; bi = bi < 0 ? 0 : (bi > 30 ? 30 : bi);
                    a[j] = ok ? a[j] * 0.125f + brow[bi] : -INFINITY; }
                sc[2 * w + hf] = a; }
    }
    float mx = -INFINITY;
#pragma unroll
    for (int i = 0; i < 17; ++i) mx = fmaxf(mx, fmaxf(fmaxf(sc[i][0], sc[i][1]), fmaxf(sc[i][2], sc[i][3])));
    mx = fmaxf(mx, __shfl_xor(mx, 16)); mx = fmaxf(mx, __shfl_xor(mx, 32));
    float sum = 0.f;
#pragma unroll
    for (int i = 0; i < 17; ++i)
#pragma unroll
        for (int j = 0; j < 4; ++j) { const float e = __builtin_amdgcn_exp2f((sc[i][j] - mx) * 1.4426950408889634f); sc[i][j] = e; sum += e; }
    sum += __shfl_xor(sum, 16); sum += __shfl_xor(sum, 32);
    f32x4 o4[4] = {z4, z4, z4, z4};
    const int vl = (4 * kg + ((lane & 15) >> 2)) * 192 + 8 * (lane & 3);
    auto chunk = [&](int vrow0, const f32x4& pa, const f32x4& pbv) {
#pragma unroll
        for (int i = 0; i < 4; ++i) { const int row = (lane >> 3) + 8 * i, ch = lane & 7;
            const u32x4 v = *(const u32x4*)(U + (size_t)(vrow0 + row) * INP + U_NAV + 64 * h + 8 * ch);
            *(LAS u32x4*)(wv + row * 192 + 16 * ch) = v; }
        u32x4 w; w.x = cvtpk(pa[0], pa[1]); w.y = cvtpk(pa[2], pa[3]); w.z = cvtpk(pbv[0], pbv[1]); w.w = cvtpk(pbv[2], pbv[3]);
        const bf16x8 bfr = __builtin_bit_cast(bf16x8, w);
#pragma unroll
        for (int c = 0; c < 4; ++c) { const s16x4 lo = vtr(wv + vl + 32 * c), hh = vtr(wv + vl + 16 * 192 + 32 * c);
            const bf16x8 va = (bf16x8){lo[0], lo[1], lo[2], lo[3], hh[0], hh[1], hh[2], hh[3]};
            o4[c] = __builtin_amdgcn_mfma_f32_16x16x32_bf16(va, bfr, o4[c], 0, 0, 0); }
    };
    chunk(mbase, sc[16], z4);
    if (!metaq) {
#pragma unroll
        for (int w = 0; w < 8; ++w) chunk(rbase + (rs + w) * 64 + kc0, sc[2 * w], sc[2 * w + 1]);
    }
    const float iv = 1.0f / sum;
    bf16_t* dst = XO + (size_t)qrow * 1024 + 64 * h + 4 * kg;
#pragma unroll
    for (int c = 0; c < 4; ++c) *(u32x2*)(dst + 16 * c) = (u32x2){cvtpk(o4[c][0] * iv, o4[c][1] * iv), cvtpk(o4[c][2] * iv, o4[c][3] * iv)};
}

DI void na_task_fast(LAS unsigned char* wv, const LAS float* btab, const Params& p, int seq, int r, int rows, int cb, int h) {
    const bf16_t* U = (const bf16_t*)(p.ws + WS_BIG); bf16_t* XO = (bf16_t*)(p.ws + WS_XO);
    const int lane = opaque_tid() & 63, m16 = lane & 15, kg = lane >> 4;
    const int rbase = seq < 8 ? seq * 8192 : 65536 + (seq - 8) * 2048, mbase = METAB + 16 * seq;
    const int qrow = rbase + r * 64 + 16 * cb + m16;
    bf16x8 qf[2];
#pragma unroll
    for (int s = 0; s < 2; ++s) qf[s] = *(const bf16x8*)(U + (size_t)qrow * INP + U_NAQ + 64 * h + 32 * s + 8 * kg);
    int rs = r - 4; rs = rs < 0 ? 0 : (rs > rows - 8 ? rows - 8 : rs);
    const int kc0 = cb == 0 ? 0 : (cb == 1 ? 8 : (cb == 2 ? 24 : 32));
    const int qc = 16 * cb + m16; int wsq = qc - 8; wsq = wsq < 0 ? 0 : (wsq > 48 ? 48 : wsq);
    const f32x4 z4 = {0.f, 0.f, 0.f, 0.f};
    f32x4 sc[17];
    const bf16_t* kbase = U + (size_t)(rbase + rs * 64 + kc0 + m16) * INP + U_NAK + 64 * h + 8 * kg;
    const bf16_t* vbase = U + (size_t)(rbase + rs * 64 + kc0 + (lane >> 3)) * INP + U_NAV + 64 * h + 8 * (lane & 7);
    const bf16_t* vmeta = U + (size_t)(mbase + (lane >> 3)) * INP + U_NAV + 64 * h + 8 * (lane & 7);
    bf16x8 km[2], ka[4][2], kb[4][2], kc[4][2];
#define NA_KLOAD(K, B) _Pragma("unroll") for (int i_ = 0; i_ < 4; ++i_) { const bf16_t* kp_ = kbase + (size_t)((((B) * 4 + i_) >> 1) * 64 + 16 * (i_ & 1)) * INP; K[i_][0] = *(const bf16x8*)kp_; K[i_][1] = *(const bf16x8*)(kp_ + 32); }
#define NA_KCOMP(K, B) _Pragma("unroll") for (int i_ = 0; i_ < 4; ++i_) { const int w_ = ((B) * 4 + i_) >> 1, hf_ = i_ & 1; \
        f32x4 a_ = __builtin_amdgcn_mfma_f32_16x16x32_bf16(K[i_][0], qf[0], z4, 0, 0, 0); a_ = __builtin_amdgcn_mfma_f32_16x16x32_bf16(K[i_][1], qf[1], a_, 0, 0, 0); \
        const LAS float* brow_ = btab + h * 465 + (rs + w_ - r + 7) * 31; \
        _Pragma("unroll") for (int j_ = 0; j_ < 4; ++j_) { const int kc_ = kc0 + 16 * hf_ + 4 * kg + j_; const bool ok_ = (kc_ >= wsq) && (kc_ < wsq + 16); \
            int bi_ = kc_ - qc + 15; bi_ = bi_ < 0 ? 0 : (bi_ > 30 ? 30 : bi_); a_[j_] = ok_ ? a_[j_] * 0.125f + brow_[bi_] : -INFINITY; } \
        sc[(B) * 4 + i_] = a_; }
    { const bf16_t* kp = U + (size_t)(mbase + m16) * INP + U_NAK + 64 * h + 8 * kg; km[0] = *(const bf16x8*)kp; km[1] = *(const bf16x8*)(kp + 32); }
    NA_KLOAD(ka, 0); NA_KLOAD(kb, 1); NA_KLOAD(kc, 2);
    __builtin_amdgcn_sched_barrier(0);
    { f32x4 a = __builtin_amdgcn_mfma_f32_16x16x32_bf16(km[0], qf[0], z4, 0, 0, 0); a = __builtin_amdgcn_mfma_f32_16x16x32_bf16(km[1], qf[1], a, 0, 0, 0); sc[16] = a * 0.125f; }
    NA_KCOMP(ka, 0); NA_KLOAD(ka, 3);
    __builtin_amdgcn_sched_barrier(0);
    NA_KCOMP(kb, 1);
    __builtin_amdgcn_sched_barrier(0);
    u32x4 pre[3][4];
#define NA_VLOAD(S, C) _Pragma("unroll") for (int i_ = 0; i_ < 4; ++i_) pre[S][i_] = *(const u32x4*)(((C) == 0 ? vmeta : vbase + (size_t)(((C) - 1) * 64) * INP) + (size_t)(8 * i_) * INP);
    NA_VLOAD(0, 0); NA_VLOAD(1, 1);
    __builtin_amdgcn_sched_barrier(0);
    NA_KCOMP(kc, 2);
    __builtin_amdgcn_sched_barrier(0);
    NA_KCOMP(ka, 3);
    float mx = -INFINITY;
#pragma unroll
    for (int i = 0; i < 17; ++i) mx = fmaxf(mx, fmaxf(fmaxf(sc[i][0], sc[i][1]), fmaxf(sc[i][2], sc[i][3])));
    mx = fmaxf(mx, __shfl_xor(mx, 16)); mx = fmaxf(mx, __shfl_xor(mx, 32));
    float sum = 0.f;
#pragma unroll
    for (int i = 0; i < 17; ++i)
#pragma unroll
        for (int j = 0; j < 4; ++j) { const float e = __builtin_amdgcn_exp2f((sc[i][j] - mx) * 1.4426950408889634f); sc[i][j] = e; sum += e; }
    sum += __shfl_xor(sum, 16); sum += __shfl_xor(sum, 32);
    f32x4 o4[4] = {z4, z4, z4, z4};
    const int vl = (4 * kg + ((lane & 15) >> 2)) * 192 + 8 * (lane & 3);
    const int wrow = (lane >> 3) * 192 + 16 * (lane & 7);
#define NA_VUSE(S, PA, PB) { _Pragma("unroll") for (int i_ = 0; i_ < 4; ++i_) *(LAS u32x4*)(wv + wrow + 8 * i_ * 192) = pre[S][i_]; \
        u32x4 w_; w_.x = cvtpk(PA[0], PA[1]); w_.y = cvtpk(PA[2], PA[3]); w_.z = cvtpk(PB[0], PB[1]); w_.w = cvtpk(PB[2], PB[3]); const bf16x8 bfr_ = __builtin_bit_cast(bf16x8, w_); \
        _Pragma("unroll") for (int c_ = 0; c_ < 4; ++c_) { const s16x4 lo_ = vtr(wv + vl + 32 * c_), hh_ = vtr(wv + vl + 16 * 192 + 32 * c_); \
            const bf16x8 va_ = (bf16x8){lo_[0], lo_[1], lo_[2], lo_[3], hh_[0], hh_[1], hh_[2], hh_[3]}; o4[c_] = __builtin_amdgcn_mfma_f32_16x16x32_bf16(va_, bfr_, o4[c_], 0, 0, 0); } }
    NA_VLOAD(2, 2); __builtin_amdgcn_sched_barrier(0);
    NA_VUSE(0, sc[16], z4);      NA_VLOAD(0, 3); __builtin_amdgcn_sched_barrier(0);
    NA_VUSE(1, sc[0], sc[1]);    NA_VLOAD(1, 4); __builtin_amdgcn_sched_barrier(0);
    NA_VUSE(2, sc[2], sc[3]);    NA_VLOAD(2, 5); __builtin_amdgcn_sched_barrier(0);
    NA_VUSE(0, sc[4], sc[5]);    NA_VLOAD(0, 6); __builtin_amdgcn_sched_barrier(0);
    NA_VUSE(1, sc[6], sc[7]);    NA_VLOAD(1, 7); __builtin_amdgcn_sched_barrier(0);
    NA_VUSE(2, sc[8], sc[9]);    NA_VLOAD(2, 8); __builtin_amdgcn_sched_barrier(0);
    NA_VUSE(0, sc[10], sc[11]);  __builtin_amdgcn_sched_barrier(0);
    NA_VUSE(1, sc[12], sc[13]);  __builtin_amdgcn_sched_barrier(0);
    NA_VUSE(2, sc[14], sc[15]);
#undef NA_KLOAD
#undef NA_KCOMP
#undef NA_VLOAD
#undef NA_VUSE
    const float iv = 1.0f / sum;
    bf16_t* dst = XO + (size_t)qrow * 1024 + 64 * h + 4 * kg;
#pragma unroll
    for (int c = 0; c < 4; ++c) *(u32x2*)(dst + 16 * c) = (u32x2){cvtpk(o4[c][0] * iv, o4[c][1] * iv), cvtpk(o4[c][2] * iv, o4[c][3] * iv)};
}

constexpr int Q_DAP = 8 * 6 * 33, Q_MLP = 8 * 4 * 33, Q_DAS = 16 * 6 * 9, Q_MLS = 16 * 4 * 9, Q_NA = 1536, Q_NAM = 24;
constexpr int Q_TOTAL = Q_DAP + Q_MLP + Q_DAS + Q_MLS + Q_NA + Q_NAM;
constexpr int QX_DAP = Q_DAP / 8, QX_MLP = Q_MLP / 8, QX_DAS = Q_DAS / 8, QX_MLS = Q_MLS / 8, QX_NA = Q_NA / 8, QX_NAM = Q_NAM / 8, QX_TOTAL = Q_TOTAL / 8;

DI void attn_phase(LAS unsigned char* lds, const Params& p, int layer, int ctr_idx, int only = 7) {
    const int tid = opaque_tid(), wave = __builtin_amdgcn_readfirstlane(tid >> 6);
    LAS float* btab = (LAS float*)(lds + NA_BIAS_OFF);
    const float* bsrc = p.in[10] + layer * 2790;
    for (int i = tid; i < 2790; i += 512) btab[i] = bsrc[i];
    volatile LAS unsigned* slot = (volatile LAS unsigned*)(lds + 131072);
    const int xcc = (int)(__builtin_amdgcn_s_getreg((3 << 11) | 20) & 7u);
#pragma unroll 1
    for (int qi = 0; qi < 8; ++qi) {
        const int x = (xcc + qi) & 7;
        unsigned* ctr = (unsigned*)(p.ws + WS_CTL) + 64 * (ctr_idx * 8 + x);
        for (;;) {
            __syncthreads();
            if (tid == 0) *slot = atomicAdd(ctr, 1u);
            __syncthreads();
            int idx = (int)*slot;
            if (idx >= QX_TOTAL) break;
#ifndef NO_DA
            if (idx < QX_DAP) { if (!(only & 1) || (layer == 1 && idx % 33 == 32)) continue; const int pair = x * 6 + idx / 33; flash_unit<2, 32>(lds, p, layer, pair / 6, pair % 6, idx % 33); continue; }
#endif
            idx -= QX_DAP;
#ifndef NO_MLA
            if (idx < QX_MLP) { if (!(only & 2) || (layer == 1 && idx % 33 == 32)) continue; const int pair = x * 4 + idx / 33; flash_unit<1, 96>(lds, p, layer, pair / 4, pair % 4, idx % 33); continue; }
#endif
            idx -= QX_MLP;
#ifndef NO_DA
            if (idx < QX_DAS) { if (!(only & 1) || (layer == 1 && idx % 9 == 8)) continue; const int pair = x * 12 + idx / 9; flash_unit<2, 32>(lds, p, layer, 8 + pair / 6, pair % 6, idx % 9); continue; }
#endif
            idx -= QX_DAS;
#ifndef NO_MLA
            if (idx < QX_MLS) { if (!(only & 2) || (layer == 1 && idx % 9 == 8)) continue; const int pair = x * 8 + idx / 9; flash_unit<1, 96>(lds, p, layer, 8 + pair / 4, pair % 4, idx % 9); continue; }
#endif
            idx -= QX_MLS;
            if (!(only & 4)) continue;
#ifndef NO_NA
            LAS unsigned char* wv = lds + NA_V_OFF + wave * NA_V_WAVE;
            if (idx < QX_NA) {
                const int gr = x * QX_NA + idx;
                int seq, r, rows;
                if (gr < 1024) { seq = gr >> 7; r = gr & 127; rows = 128; } else { seq = 8 + ((gr - 1024) >> 5); r = (gr - 1024) & 31; rows = 32; }
#pragma unroll 1
                for (int i = 0; i < 3; ++i) { const int id = wave + 8 * i; na_task_fast(wv, btab, p, seq, r, rows, id & 3, id >> 2); }
                continue; }
            idx -= QX_NA;
            if (layer == 0 && wave < 6) na_task(wv, btab, p, x * 3 + idx, 0, 8, 0, wave, true);
#endif
        }
    }
}

#define RLX_AGENT __ATOMIC_RELAXED, __HIP_MEMORY_SCOPE_AGENT
#define XB_TMO      128
#define XB_XCNT(j)  (256  + 64 * (j))
#define XB_XSUB(j)  (1280 + 64 * (j))
#define XB_XGEN(j)  (2304 + 64 * (j))
#define XB_TOP      3328
#define XB_TOPGEN   3392
#define XCD_BAR_WORDS 3456
#define XB_SPIN_CAP (1u << 18)

__device__ __forceinline__ unsigned xb_ld(unsigned* p)              { return __hip_atomic_load(p, __ATOMIC_RELAXED, __HIP_MEMORY_SCOPE_AGENT); }
__device__ __forceinline__ unsigned xb_add(unsigned* p, unsigned v) { return __hip_atomic_fetch_add(p, v, __ATOMIC_RELAXED, __HIP_MEMORY_SCOPE_AGENT); }
__device__ __forceinline__ unsigned xb_xcc_id() { return (unsigned)__builtin_amdgcn_s_getreg((3 << 11) | 20) & 0xFu; }
#define XB_SPIN(cond, bar) do { unsigned _sp = 0; while (cond) { __builtin_amdgcn_s_sleep(1); \
    if ((++_sp & 255u) == 0u) { if (xb_ld(&(bar)[XB_TMO])) break; if (_sp > XB_SPIN_CAP) { atomicAdd(&(bar)[XB_TMO], 1u); break; } } } } while (0)

struct XcdBarrier {
    unsigned* bar; unsigned x;
    volatile LAS unsigned* st;
};

__device__ __forceinline__ XcdBarrier xcd_barrier_post(unsigned* bar, volatile LAS unsigned* st) {
    XcdBarrier b; b.bar = bar; b.x = xb_xcc_id(); b.st = st;
    if (threadIdx.x == 0) (void)xb_add(&bar[XB_XCNT(b.x)], 1u);
    return b;
}
__device__ __forceinline__ void xcd_barrier_complete(unsigned* bar, unsigned x, unsigned& nloc, unsigned& nx) {
    const unsigned G = gridDim.x * gridDim.y * gridDim.z;
    unsigned sum, cnt, mine, sp = 0u;
    for (;;) {
        sum = 0u; cnt = 0u; mine = 0u;
#pragma unroll
        for (unsigned j = 0; j < 16; ++j) { const unsigned c = xb_ld(&bar[XB_XCNT(j)]); sum += c; cnt += (c > 0u) ? 1u : 0u; mine = (j == x) ? c : mine; }
        if (sum == G) break;
        __builtin_amdgcn_s_sleep(1);
        if ((++sp & 255u) == 0u) { if (xb_ld(&bar[XB_TMO])) break; if (sp > XB_SPIN_CAP) { atomicAdd(&bar[XB_TMO], 1u); break; } }
    }
    nloc = mine > 0u ? mine : 1u; nx = cnt > 0u ? cnt : 1u;
}

__device__ __forceinline__ void xcd_barrier(const XcdBarrier& b) {
    asm volatile("s_waitcnt vmcnt(0)" ::: "memory");
    __syncthreads();
    if (threadIdx.x == 0) {
        unsigned* bar = b.bar;
        __builtin_amdgcn_s_waitcnt(0);
        unsigned nloc = b.st[0], nx = b.st[1];
        if (nloc == 0u) { xcd_barrier_complete(bar, b.x, nloc, nx); b.st[0] = nloc; b.st[1] = nx; }
        const unsigned old = xb_add(&bar[XB_XSUB(b.x)], 1u);
        const unsigned gen = old / nloc;
        if (old + 1u == (gen + 1u) * nloc) {
            __builtin_amdgcn_fence(__ATOMIC_RELEASE, "agent");
            asm volatile("s_waitcnt vmcnt(0)" ::: "memory");
            const unsigned og = xb_add(&bar[XB_TOP], 1u);
            const unsigned tg = og / nx;
            if (og + 1u == (tg + 1u) * nx) xb_add(&bar[XB_TOPGEN], 1u);
            else XB_SPIN(xb_ld(&bar[XB_TOPGEN]) == tg, bar);
            __builtin_amdgcn_fence(__ATOMIC_ACQUIRE, "agent");
            xb_add(&bar[XB_XGEN(b.x)], 1u);
            asm volatile("s_waitcnt vmcnt(0)" ::: "memory");
        } else {
            XB_SPIN(xb_ld(&bar[XB_XGEN(b.x)]) == gen, bar);
            __builtin_amdgcn_fence(__ATOMIC_ACQUIRE, "agent");
            asm volatile("s_waitcnt vmcnt(0)" ::: "memory");
        }
    }
    __syncthreads();
}

__global__ void __launch_bounds__(512, 2) fwd_megakernel(Params p) {
    extern __shared__ __attribute__((aligned(16))) unsigned char lds_raw[];
    LAS unsigned char* lds = (LAS unsigned char*)lds_raw;
    cg::grid_group grid = cg::this_grid();
    const int tid = threadIdx.x, lane = tid & 63, wave = __builtin_amdgcn_readfirstlane(tid >> 6);
    const int G = gridDim.x, gw = blockIdx.x * 8 + wave, NGW = G * 8;
    unsigned char* ws = p.ws;
    bf16_t* XO = (bf16_t*)(ws + WS_XO); bf16_t* BIG = (bf16_t*)(ws + WS_BIG); bf16_t* QM = (bf16_t*)(ws + WS_QKVM);
    float* hmeta_adj = (float*)(ws + WS_HMETA) - (size_t)NREAL * D;

#if PH & 1
    if (tid < 2) ((volatile LAS unsigned*)(lds + 131072 + 16))[tid] = 0u;
    __syncthreads();
    const XcdBarrier xbar = xcd_barrier_post((unsigned*)(ws + WS_CTL) + 4096, (volatile LAS unsigned*)(lds + 131072 + 16));
    prologue(p, lds, gw, NGW, wave, lane);
#endif
#if PH & 2
    norm_rows<1>(p, p.in[3], gw, NGW, lane);
#endif
    grid.sync();
#define RESID_GEMM_NORM(GA, GB, GK, GLDA, EPI, NEXT_G, META) do { \
        { pg8::Gemm g_{GA, GB, NREAL, 1024, GK, GLDA}; pg8::StaticOrder S_; S_.init(NREAL, 1024, G, (int)blockIdx.x); pg8::gemm_phase(lds, g_, S_, EPI); } \
        xcd_barrier(xbar); \
        if ((NEXT_G) != nullptr && !(META)) { norm_rows<0>(p, NEXT_G, gw, NGW, lane, 0, NREAL, 0); xcd_barrier(xbar); } \
        else if ((NEXT_G) != nullptr) { \
            if (blockIdx.x < 8) { pg8::Gemm g_{GA, GB, MP, 1024, GK, GLDA}; pg8::MetaOrder S_{(int)blockIdx.x}; pg8::gemm_phase(lds, g_, S_, EPI); } \
            else norm_rows<0>(p, NEXT_G, gw, (G - 8) * 8, lane, 0, NREAL, 8); \
            xcd_barrier(xbar); \
            norm_rows<0>(p, NEXT_G, gw, NGW, lane, NREAL, MP, 0); \
            xcd_barrier(xbar); } } while (0)
#pragma unroll 1
    for (int l = 0; l < 2; ++l) {
#pragma unroll 1
        for (int f = 0; f < 2; ++f) {
            { const int Mg = (l == 1 && f == 1) ? NREAL : MP;
              pg8::Gemm g{XO, (const bf16_t*)(ws + WS_WGU) + (size_t)(l * 2 + f) * 5632 * 1024, Mg, 5632, 1024, 1024}; pg8::StaticOrder S; S.init(Mg, 5632, G, (int)blockIdx.x);
              pg8::EpiSwiGLU E{BIG, DFF}; pg8::gemm_phase(lds, g, S, E); }
            xcd_barrier(xbar);
            { pg8::EpiResid E{p.out, hmeta_adj, 0.5f, (l == 0 && f == 0) ? p.in[0] : nullptr, p.in[1] - (size_t)65536 * D};
              const float* next_g = (f == 0) ? p.in[3] + (l * 3 + 1) * D : (l == 0 ? p.in[3] + 3 * D : (const float*)nullptr);
              RESID_GEMM_NORM(BIG, (const bf16_t*)(ws + WS_WDN) + (size_t)(l * 2 + f) * 1024 * 2816, 2816, 2816, E, next_g, true); }
            if (f == 0) {
                { pg8::Gemm g{XO, (const bf16_t*)(ws + WS_WIN) + (size_t)l * 2816 * 1024, MP, 2816, 1024, 1024}; pg8::StaticOrder S; S.init(MP, 2816, G, (int)blockIdx.x);
                  pg8::EpiU E{BIG, p.in[13] + l * 256, p.in[14] + l * 128, (const float*)(ws + WS_TABD), (const float*)(ws + WS_TABD) + 8208 * 4, (const float*)(ws + WS_TABM), (const float*)(ws + WS_TABM) + 8208 * 16, (LAS float*)(lds + EPIU_X_OFF)};
                  pg8::gemm_phase(lds, g, S, E); }
                xcd_barrier(xbar);
                { pg8::Gemm g{BIG + U_CQ, (const bf16_t*)(ws + WS_WMLA) + (size_t)l * 1024 * 384, MP, 1024, 384, INP}; pg8::StaticOrder S; S.init(MP, 1024, G, (int)blockIdx.x);
                  pg8::EpiBf16 E{QM, 1024}; pg8::gemm_phase(lds, g, S, E); }
                xcd_barrier(xbar);
                attn_phase(lds, p, l, l);
                xcd_barrier(xbar);
                { pg8::EpiResid E{p.out, hmeta_adj, 1.0f, nullptr, nullptr};
                  RESID_GEMM_NORM(XO, (const bf16_t*)(ws + WS_WOUT) + (size_t)l * 1024 * 1024, 1024, 1024, E, p.in[3] + (l * 3 + 2) * D, l == 0); }
            }
        }
    }
#undef RESID_GEMM_NORM
#if PH & 512
    final_rows(p, gw, NGW, lane);
#endif
}

extern "C" void kernel_launch(void* const* d_in, const int* in_sizes, int n_in, void* d_out, int out_size, void* d_ws, size_t ws_size, hipStream_t stream) {
    static int grid = 0;
    if (grid == 0) {
        if (n_in != 17 || ws_size < WS_END) { fprintf(stderr, "kernel_launch: unexpected n_in %d / ws_size %zu (need %zu)\n", n_in, ws_size, (size_t)WS_END); grid = -1; return; }
        int dev = 0, cus = 0, per_cu = 0;
        hipGetDevice(&dev);
        hipDeviceGetAttribute(&cus, hipDeviceAttributeMultiprocessorCount, dev);
        hipFuncSetAttribute((const void*)fwd_megakernel, hipFuncAttributeMaxDynamicSharedMemorySize, LDS_BYTES);
        hipOccupancyMaxActiveBlocksPerMultiprocessor(&per_cu, (const void*)fwd_megakernel, 512, LDS_BYTES);
        if (per_cu < 1) { fprintf(stderr, "kernel_launch: occupancy query returned %d\n", per_cu); per_cu = 1; }
        grid = cus * 1;
        (void)hipGetLastError();
    }
    if (grid < 0) return;
    hipMemsetAsync((char*)d_ws + WS_CTL, 0, 32768, stream);
    Params p{};
    for (int i = 0; i < 17; ++i) p.in[i] = (const float*)d_in[i];
    p.out = (float*)d_out; p.ws = (unsigned char*)d_ws;
    void* args[] = {&p};
    hipError_t e = hipLaunchCooperativeKernel((const void*)fwd_megakernel, dim3(grid), dim3(512), args, LDS_BYTES, stream);
    if (e != hipSuccess) fprintf(stderr, "cooperative launch failed: %s (grid %d)\n", hipGetErrorString(e), grid);
}
```

```cpp
#include <hip/hip_runtime.h>
#include <hip/hip_cooperative_groups.h>
#include <cstdio>
#include <cstdint>
namespace cg = cooperative_groups;
#ifndef PH
#define PH 1023
#endif

#define LAS __attribute__((address_space(3)))
typedef unsigned short bf16_t;
typedef short bf16x8 __attribute__((ext_vector_type(8)));
typedef short s16x4 __attribute__((ext_vector_type(4)));
typedef float f32x4 __attribute__((ext_vector_type(4)));
typedef float f32x2 __attribute__((ext_vector_type(2)));
typedef float f32x16 __attribute__((ext_vector_type(16)));
typedef unsigned u32x4 __attribute__((ext_vector_type(4)));
typedef unsigned u32x2 __attribute__((ext_vector_type(2)));
typedef __bf16 bf16x2_t __attribute__((ext_vector_type(2)));
#define DI __device__ __forceinline__

constexpr int D = 1024, DFF = 2816, INW = 2720, INP = 2816;
constexpr int NREAL = 98304, MR = 98688, MP = 98816;
constexpr int METAB = 98304;
constexpr float EPS = 1e-6f;
constexpr int U_NAQ = 0, U_NAK = 384, U_NAV = 768, U_DAQ = 1152, U_DAK = 1536, U_DAV = 1920, U_CQ = 2304, U_CKV = 2560, U_KR = 2688;
constexpr size_t MiB = 1u << 20;
constexpr size_t WS_CTL = 0;
constexpr size_t WS_HMETA = 1 * MiB;
constexpr size_t WS_TABM = 3 * MiB;
constexpr size_t WS_TABD = WS_TABM + 2 * 8208 * 16 * 4;
constexpr size_t WS_WGU = 5 * MiB;
constexpr size_t WS_WDN = WS_WGU + 4ull * 5632 * 1024 * 2;
constexpr size_t WS_WIN = WS_WDN + 4ull * 1024 * 2816 * 2;
constexpr size_t WS_WOUT = WS_WIN + 2ull * 2816 * 1024 * 2;
constexpr size_t WS_WMLA = WS_WOUT + 2ull * 1024 * 1024 * 2;
constexpr size_t WS_XO = 89 * MiB;
constexpr size_t WS_QKVM = WS_XO + (size_t)MP * 1024 * 2;
constexpr size_t WS_BIG = WS_QKVM + (size_t)MP * 1024 * 2;
constexpr size_t WS_END = WS_BIG + (size_t)MP * 2816 * 2;
static_assert(WS_WMLA + 2ull * 1024 * 384 * 2 <= WS_XO, "ws map");
static_assert(WS_END <= 1024 * MiB, "ws map fits 1 GiB");

constexpr int LDS_BYTES = 131072 + 1024 + 11264 + 256 + 4096;
constexpr int EPIU_X_OFF = 131072 + 1024 + 11264 + 256;

DI unsigned cvtpk(float lo, float hi) { f32x2 v = {lo, hi}; bf16x2_t b = __builtin_convertvector(v, bf16x2_t); return __builtin_bit_cast(unsigned, b); }
DI float bf2f(unsigned short x) { return __uint_as_float((unsigned)x << 16); }
DI float wave_sum(float v) {
#pragma unroll
    for (int o = 1; o < 64; o <<= 1) v += __shfl_xor(v, o);
    return v;
}
DI int opaque_tid() { int t = threadIdx.x; asm volatile("" : "+v"(t)); return t; }
DI int row_pos(int r) { return r < 65536 ? 16 + (r & 8191) : (r < NREAL ? 16 + (r & 2047) : ((r - NREAL) & 15)); }
DI float swapmax(float m) { auto rr = __builtin_amdgcn_permlane32_swap(__float_as_uint(m), __float_as_uint(m), false, false); return fmaxf(__uint_as_float(rr[0]), __uint_as_float(rr[1])); }
DI float swapsum(float m) { auto rr = __builtin_amdgcn_permlane32_swap(__float_as_uint(m), __float_as_uint(m), false, false); return __uint_as_float(rr[0]) + __uint_as_float(rr[1]); }

namespace pg8 {
constexpr int BM = 256, BK = 64, HALF = 128, HTB = HALF * BK * 2, STAGE_BYTES = 8 * HTB, NXCD = 8, WGM = 8;
DI int lds_byte(int r, int c) { const int st = (r >> 4) * 2 + (c >> 5), rr = r & 15, cc = c & 31, ob = rr * 64 + cc * 2; return st * 1024 + (ob ^ (((ob >> 9) & 1) << 5)); }
DI void stage_rc(int b, int& R, int& C) { const int st = b / 1024, sb = b % 1024, swz = sb ^ (((sb >> 9) & 1) << 5); R = (st >> 1) * 16 + swz / 64; C = (st & 1) * 32 + (swz % 64) / 2; }
DI int perm32(int rho) { const int n = rho >> 4, i = rho & 15; return 8 * (i >> 2) + 4 * n + (i & 3); }
struct Unit { int pm, pn; };
struct Gemm { const bf16_t* A; const bf16_t* Bt; int M, N, K, lda; };
struct StaticOrder {
    int nM, nN, nwg, G, c;
    DI void init(int M, int N, int G_, int c_) { nM = M / BM; nN = N / BM; nwg = nM * nN; G = G_; c = c_; }
    DI bool next(int i, Unit& u) const {
        const long L = (long)i * G + c; if (L >= nwg) return false;
        int wgid = (int)L; { const int q = nwg / NXCD, r = nwg % NXCD, xcd = wgid % NXCD, off = wgid / NXCD; wgid = (xcd < r ? xcd * (q + 1) : r * (q + 1) + (xcd - r) * q) + off; }
        const int nig = WGM * nN, gid = wgid / nig, fm = gid * WGM, gsz = (nM - fm) < WGM ? (nM - fm) : WGM;
        u.pm = fm + ((wgid % nig) % gsz); u.pn = (wgid % nig) / gsz; return true;
    }
};
struct EpiBf16 {
    static constexpr bool PERM = true;
    bf16_t* O; int ldc;
    DI void operator()(const f32x4 (&acc)[2][2][4][2], const Unit& u, int wr, int wc, int fr, int fq) const {
        const int row0 = u.pm * BM + wr * 64 + fr, col0 = u.pn * BM + wc * 32 + 8 * fq;
#pragma unroll
        for (int ai = 0; ai < 2; ++ai)
#pragma unroll
            for (int m = 0; m < 4; ++m) { bf16_t* rowp = O + (size_t)(row0 + ai * HALF + m * 16) * ldc + col0;
#pragma unroll
                for (int bj = 0; bj < 2; ++bj) { const f32x4 v0 = acc[ai][bj][m][0], v1 = acc[ai][bj][m][1];
                    u32x4 w; w.x = cvtpk(v0[0], v0[1]); w.y = cvtpk(v0[2], v0[3]); w.z = cvtpk(v1[0], v1[1]); w.w = cvtpk(v1[2], v1[3]);
                    __builtin_nontemporal_store(w, (u32x4*)(rowp + bj * HALF)); }
                asm volatile("" ::: "memory"); }
    }
};
struct EpiU {
    static constexpr bool PERM = true;
    bf16_t* O; const float* gq; const float* gkv; const float* tdc; const float* tds; const float* tmc; const float* tms; LAS float* X;
    DI void operator()(f32x4 (&acc)[2][2][4][2], const Unit& u, int wr, int wc, int fr, int fq) const {
        const int pn = u.pn, row0 = u.pm * BM + wr * 64 + fr, col0 = pn * BM + wc * 32 + 8 * fq;
        const bool normt = (pn == 9 || pn == 10);
        if (normt) {
            const int nbj = (pn == 9) ? 2 : 1;
#pragma unroll
            for (int ai = 0; ai < 2; ++ai)
#pragma unroll
                for (int m = 0; m < 4; ++m) { float ss = 0.f;
#pragma unroll
                    for (int bj = 0; bj < 2; ++bj) if (bj < nbj) {
#pragma unroll
                        for (int n = 0; n < 2; ++n) { const f32x4 v = acc[ai][bj][m][n]; ss += (v[0] * v[0] + v[1] * v[1]) + (v[2] * v[2] + v[3] * v[3]); } }
                    ss += __shfl_xor(ss, 16); ss += __shfl_xor(ss, 32);
                    if (fq == 0) X[(ai * HALF + wr * 64 + m * 16 + fr) * 4 + wc] = ss; }
            asm volatile("s_waitcnt lgkmcnt(0)" ::: "memory"); __builtin_amdgcn_s_barrier(); asm volatile("" ::: "memory");
        }
        const bool da_t0 = (pn == 5 || pn == 6 || pn == 7), da_t1 = (pn == 4 || pn == 5 || pn == 6);
#pragma unroll
        for (int ai = 0; ai < 2; ++ai)
#pragma unroll
            for (int m = 0; m < 4; ++m) { const int row = row0 + ai * HALF + m * 16; bf16_t* rowp = O + (size_t)row * INP + col0;
                const int pos = row < 65536 ? 16 + (row & 8191) : (row < NREAL ? 16 + (row & 2047) : ((row - NREAL) & 15));
                float rs = 1.0f;
                if (normt) { const f32x4 pr = *(const LAS f32x4*)(X + (ai * HALF + wr * 64 + m * 16 + fr) * 4);
                    rs = 1.0f / sqrtf(((pr[0] + pr[1]) + (pr[2] + pr[3])) * (pn == 9 ? (1.0f / 256.0f) : (1.0f / 128.0f)) + 1e-6f); }
#pragma unroll
                for (int bj = 0; bj < 2; ++bj) { f32x4 v0 = acc[ai][bj][m][0], v1 = acc[ai][bj][m][1];
                    if (pn == 9 || (pn == 10 && bj == 0)) {
                        const float* gp = (pn == 9 ? gq + bj * HALF : gkv) + wc * 32 + 8 * fq;
                        v0 = v0 * rs * *(const f32x4*)gp; v1 = v1 * rs * *(const f32x4*)(gp + 4);
                    } else if ((bj == 0 && da_t0) || (bj == 1 && da_t1)) {
                        const f32x4 c = *(const f32x4*)(tdc + pos * 4), sn = *(const f32x4*)(tds + pos * 4);
                        const f32x4 y0 = v0 * c - v1 * sn, y1 = v1 * c + v0 * sn;
                        if (fq == 0) { v0 = y0; v1 = y1; }
                    } else if (pn == 10 && bj == 1 && wc == 0) {
                        const int fi = 8 * (fq & 1);
                        const f32x4 c0 = *(const f32x4*)(tmc + pos * 16 + fi), c1 = *(const f32x4*)(tmc + pos * 16 + fi + 4), s0 = *(const f32x4*)(tms + pos * 16 + fi), s1 = *(const f32x4*)(tms + pos * 16 + fi + 4);
                        f32x4 p0, p1;
#pragma unroll
                        for (int e = 0; e < 4; ++e) { p0[e] = __shfl_xor(v0[e], 32); p1[e] = __shfl_xor(v1[e], 32); }
                        if (fq < 2) { v0 = v0 * c0 - p0 * s0; v1 = v1 * c1 - p1 * s1; }
                        else        { v0 = v0 * c0 + p0 * s0; v1 = v1 * c1 + p1 * s1; }
                    }
                    u32x4 w; w.x = cvtpk(v0[0], v0[1]); w.y = cvtpk(v0[2], v0[3]); w.z = cvtpk(v1[0], v1[1]); w.w = cvtpk(v1[2], v1[3]);
                    __builtin_nontemporal_store(w, (u32x4*)(rowp + bj * HALF)); }
                asm volatile("" ::: "memory"); }
    }
};
DI float silu_mul(float g, float u) { return g * u * __builtin_amdgcn_rcpf(1.0f + __builtin_amdgcn_exp2f(-1.4426950408889634f * g)); }
struct EpiSwiGLU {
    static constexpr bool PERM = true;
    bf16_t* O; int ldc;
    DI void operator()(const f32x4 (&acc)[2][2][4][2], const Unit& u, int wr, int wc, int fr, int fq) const {
        const int row0 = u.pm * BM + wr * 64 + fr, col0 = u.pn * HALF + wc * 32 + 8 * fq;
#pragma unroll
        for (int ai = 0; ai < 2; ++ai)
#pragma unroll
            for (int m = 0; m < 4; ++m) { bf16_t* rowp = O + (size_t)(row0 + ai * HALF + m * 16) * ldc + col0;
                const f32x4 g0 = acc[ai][0][m][0], g1 = acc[ai][0][m][1], u0 = acc[ai][1][m][0], u1 = acc[ai][1][m][1];
                u32x4 w; w.x = cvtpk(silu_mul(g0[0], u0[0]), silu_mul(g0[1], u0[1])); w.y = cvtpk(silu_mul(g0[2], u0[2]), silu_mul(g0[3], u0[3]));
                w.z = cvtpk(silu_mul(g1[0], u1[0]), silu_mul(g1[1], u1[1])); w.w = cvtpk(silu_mul(g1[2], u1[2]), silu_mul(g1[3], u1[3]));
                __builtin_nontemporal_store(w, (u32x4*)rowp); asm volatile("" ::: "memory"); }
    }
};
struct EpiResid {
    static constexpr bool PERM = false;
    float* hmain; float* hmeta_adj; float s; const float* xp; const float* xs_adj;
    DI void operator()(const f32x4 (&acc)[2][2][4][2], const Unit& u, int wr, int wc, int fr, int fq) const {
        const int row0 = u.pm * BM + wr * 64 + fr, col0 = u.pn * BM + wc * 32 + 4 * fq;
        float* base = (u.pm < 384) ? hmain : hmeta_adj;
        const float* rbase = (xp != nullptr && u.pm < 384) ? (u.pm < 256 ? xp : xs_adj) : base;
#pragma unroll
        for (int ai = 0; ai < 2; ++ai) {
            f32x4 hv[4][2][2];
#pragma unroll
            for (int m = 0; m < 4; ++m) { const float* rowp = rbase + (size_t)(row0 + ai * HALF + m * 16) * D + col0;
#pragma unroll
                for (int bj = 0; bj < 2; ++bj)
#pragma unroll
                    for (int n = 0; n < 2; ++n) hv[m][bj][n] = *(const f32x4*)(rowp + bj * HALF + n * 16); }
            asm volatile("" ::: "memory");
#pragma unroll
            for (int m = 0; m < 4; ++m) { float* rowp = base + (size_t)(row0 + ai * HALF + m * 16) * D + col0;
#pragma unroll
                for (int bj = 0; bj < 2; ++bj)
#pragma unroll
                    for (int n = 0; n < 2; ++n) *(f32x4*)(rowp + bj * HALF + n * 16) = hv[m][bj][n] + acc[ai][bj][m][n] * s; }
            asm volatile("" ::: "memory"); }
    }
};
DI void glds16s(const char* sbase, unsigned voff, unsigned ldsaddr) {
    unsigned keep; const unsigned la = (unsigned)__builtin_amdgcn_readfirstlane((int)ldsaddr);
    asm volatile("s_mov_b32 %0, m0\n\ts_mov_b32 m0, %3\n\ts_nop 0\n\tglobal_load_lds_dwordx4 %1, %2\n\ts_mov_b32 m0, %0" : "=&s"(keep) : "v"(voff), "s"(sbase), "s"(la) : "memory");
}
struct MetaOrder {
    int c;
    DI bool next(int i, Unit& u) const { if (i != 0 || c >= 8) return false; u.pm = 384 + (c >> 2); u.pn = c & 3; return true; }
};
template <class Epi, class Sched>
DI void gemm_phase(LAS unsigned char* lds, const Gemm g, const Sched& S, const Epi& E) {
    int tid_ = threadIdx.x; asm volatile("" : "+v"(tid_));
    const int tid = tid_, wid = __builtin_amdgcn_readfirstlane(tid >> 6), lane = tid & 63, wr = wid >> 2, wc = wid & 3, fr = lane & 15, fq = lane >> 4;
    const int K = g.K, lda = g.lda; int nt = K / BK; asm volatile("" : "+s"(nt));
    unsigned voffA[2], voffB[2];
#pragma unroll
    for (int i = 0; i < 2; ++i) { int R, C; stage_rc(tid * 16 + i * 8192, R, C); const int Rb = Epi::PERM ? ((R & ~31) + perm32(R & 31)) : R;
        voffA[i] = (unsigned)(R * lda + C) * 2u; voffB[i] = (unsigned)(Rb * K + C) * 2u; }
    const size_t kstep = (size_t)(BK * 2);
    const size_t hstepA = (size_t)HALF * lda * 2, hstepB = (size_t)HALF * K * 2;
    const size_t tstepA = 2 * hstepA, tstepB = 2 * hstepB;
    const unsigned ldsbase = (unsigned)(uintptr_t)lds + (unsigned)wid * 1024u;
    const int aoff = lds_byte(wr * 64 + fr, fq * 8), boff = lds_byte(wc * 32 + fr, fq * 8);
#define PG8_SA(b, h) (((b) * 2 + (h)) * HTB)
#define PG8_SB(b, h) ((4 + (b) * 2 + (h)) * HTB)
#define PG8_STAGE(bufoff, gbase, voff) do { _Pragma("unroll") for (int _i = 0; _i < 2; ++_i) \
        glds16s((const char*)(gbase), (voff)[_i], ldsbase + (unsigned)((bufoff) + _i * 8192)); } while (0)
#define PG8_LDA(dst, b, h) do { _Pragma("unroll") for (int m = 0; m < 4; ++m) _Pragma("unroll") for (int k = 0; k < 2; ++k) dst[m][k] = *(const LAS bf16x8*)(lds + PG8_SA(b, h) + aoff + m * 2048 + k * 1024); } while (0)
#define PG8_LDB(dst, b, h) do { _Pragma("unroll") for (int n = 0; n < 2; ++n) _Pragma("unroll") for (int k = 0; k < 2; ++k) dst[n][k] = *(const LAS bf16x8*)(lds + PG8_SB(b, h) + boff + n * 2048 + k * 1024); } while (0)
#define PG8_MMA(ai, bj, At, Bt) do { __builtin_amdgcn_s_setprio(1); _Pragma("unroll") for (int m = 0; m < 4; ++m) _Pragma("unroll") for (int n = 0; n < 2; ++n) _Pragma("unroll") for (int k = 0; k < 2; ++k) \
        acc[ai][bj][m][n] = __builtin_amdgcn_mfma_f32_16x16x32_bf16(Bt[n][k], At[m][k], acc[ai][bj][m][n], 0, 0, 0); __builtin_amdgcn_s_setprio(0); } while (0)
#define PG8_WAIT_V(n) asm volatile("s_waitcnt vmcnt(" #n ")" ::: "memory")
#define PG8_WAIT_L(n) asm volatile("s_waitcnt lgkmcnt(" #n ")" ::: "memory")
#define PG8_BAR __builtin_amdgcn_s_barrier()
#define PG8_SCHED __builtin_amdgcn_sched_barrier(0)
    Unit cur, nxt; int ui = 0;
    if (!S.next(0, cur)) return;
    const char* gA = (const char*)g.A; const char* gB = (const char*)g.Bt;
    asm volatile("" : "+s"(gA), "+s"(gB));
    f32x4 acc[2][2][4][2];
#pragma unroll
    for (int a = 0; a < 2; ++a)
#pragma unroll
        for (int b = 0; b < 2; ++b)
#pragma unroll
            for (int m = 0; m < 4; ++m)
#pragma unroll
                for (int n = 0; n < 2; ++n) acc[a][b][m][n] = (f32x4){0.f, 0.f, 0.f, 0.f};
    bf16x8 At[4][2], B0[2][2], B1[2][2];
    const char* cA = gA + (size_t)cur.pm * tstepA; const char* cB = gB + (size_t)cur.pn * tstepB;
    PG8_STAGE(PG8_SB(0, 0), cB, voffB); PG8_STAGE(PG8_SB(0, 1), cB + hstepB, voffB); PG8_STAGE(PG8_SA(0, 0), cA, voffA); PG8_STAGE(PG8_SA(0, 1), cA + hstepA, voffA);
    if (wr == 1) PG8_BAR;
    PG8_WAIT_V(2); PG8_BAR;
    PG8_STAGE(PG8_SB(1, 0), cB + kstep, voffB); PG8_STAGE(PG8_SA(1, 0), cA + kstep, voffA); PG8_STAGE(PG8_SB(1, 1), cB + hstepB + kstep, voffB);
    PG8_WAIT_V(6); PG8_BAR;
    for (;;) {
        const bool has_next = S.next(ui + 1, nxt);
        const char* nA = has_next ? gA + (size_t)nxt.pm * tstepA : cA; const char* nB = has_next ? gB + (size_t)nxt.pn * tstepB : cB;
        for (int t = 0; t < nt; t += 2) {
            const bool last = (t == nt - 2);
            const char* a1 = cA + (size_t)(t + 1) * kstep;
            const char* a2 = last ? nA : cA + (size_t)(t + 2) * kstep; const char* b2 = last ? nB : cB + (size_t)(t + 2) * kstep;
            const char* a3 = a2 + kstep; const char* b3 = b2 + kstep;
            PG8_LDB(B0, 0, 0); PG8_LDB(B1, 0, 1); PG8_SCHED; PG8_LDA(At, 0, 0); PG8_STAGE(PG8_SA(1, 1), a1 + hstepA, voffA);
            PG8_WAIT_V(8); PG8_WAIT_L(0); PG8_BAR; PG8_MMA(0, 0, At, B0); PG8_MMA(0, 1, At, B1); PG8_BAR; PG8_SCHED;
            PG8_LDA(At, 0, 1); PG8_STAGE(PG8_SB(0, 0), b2, voffB); PG8_STAGE(PG8_SB(0, 1), b2 + hstepB, voffB); PG8_STAGE(PG8_SA(0, 0), a2, voffA);
            PG8_WAIT_V(8); PG8_WAIT_L(0); PG8_BAR; PG8_MMA(1, 0, At, B0); PG8_MMA(1, 1, At, B1); PG8_BAR; PG8_SCHED;
            PG8_LDB(B0, 1, 0); PG8_LDB(B1, 1, 1); PG8_SCHED; PG8_LDA(At, 1, 0); PG8_STAGE(PG8_SA(0, 1), a2 + hstepA, voffA);
            PG8_WAIT_V(8); PG8_WAIT_L(0); PG8_BAR; PG8_MMA(0, 0, At, B0); PG8_MMA(0, 1, At, B1); PG8_BAR; PG8_SCHED;
            PG8_LDA(At, 1, 1); PG8_STAGE(PG8_SB(1, 0), b3, voffB); PG8_STAGE(PG8_SB(1, 1), b3 + hstepB, voffB); PG8_STAGE(PG8_SA(1, 0), a3, voffA);
            PG8_WAIT_V(8); PG8_WAIT_L(0); PG8_BAR; PG8_MMA(1, 0, At, B0); PG8_MMA(1, 1, At, B1); PG8_BAR; PG8_SCHED;
        }
        if (wr == 0) PG8_BAR;
        E(acc, cur, wr, wc, fr, fq);
        if (!has_next) break;
#pragma unroll
        for (int a = 0; a < 2; ++a)
#pragma unroll
            for (int b = 0; b < 2; ++b)
#pragma unroll
                for (int m = 0; m < 4; ++m)
#pragma unroll
                    for (int n = 0; n < 2; ++n) acc[a][b][m][n] = (f32x4){0.f, 0.f, 0.f, 0.f};
        cur = nxt; cA = nA; cB = nB; ++ui;
        if (wr == 1) PG8_BAR;
    }
    PG8_WAIT_V(0);
    PG8_BAR;
#undef PG8_SA
#undef PG8_SB
#undef PG8_STAGE
#undef PG8_LDA
#undef PG8_LDB
#undef PG8_MMA
#undef PG8_WAIT_V
#undef PG8_WAIT_L
#undef PG8_BAR
#undef PG8_SCHED
}
}

struct Params { const float* in[17]; float* out; unsigned char* ws; };

DI float* hrow(const Params& p, int r) { return r < NREAL ? p.out + (size_t)r * D : (float*)(p.ws + WS_HMETA) + (size_t)(r - NREAL) * D; }

DI void transpose_item(const float* W, int N, bf16_t* WT, int ldt, int koff, int k0, int n0, int drow0, LAS float* scr, int lane) {
#pragma unroll 8
    for (int i = 0; i < 32; ++i) { const int kk = 2 * i + (lane >> 5); scr[kk * 33 + (lane & 31)] = W[(size_t)(k0 + kk) * N + n0 + (lane & 31)]; }
    asm volatile("s_waitcnt lgkmcnt(0)" ::: "memory");
    const int c = lane & 7;
#pragma unroll
    for (int j = 0; j < 4; ++j) { const int n = (lane >> 3) + 8 * j; const LAS float* s = scr + (8 * c) * 33 + n;
        u32x4 o; o.x = cvtpk(s[0 * 33], s[1 * 33]); o.y = cvtpk(s[2 * 33], s[3 * 33]); o.z = cvtpk(s[4 * 33], s[5 * 33]); o.w = cvtpk(s[6 * 33], s[7 * 33]);
        *(u32x4*)(WT + (size_t)(drow0 + n) * ldt + koff + k0 + 8 * c) = o; }
    asm volatile("s_waitcnt lgkmcnt(0)" ::: "memory");
}

DI void prologue(const Params& p, LAS unsigned char* lds, int gw_, int NGW, int wave_, int lane_) {
    const int tid = opaque_tid(), lane = tid & 63, wave = __builtin_amdgcn_readfirstlane(tid >> 6), gw = blockIdx.x * 8 + wave;
    LAS float* scr = (LAS float*)(lds + wave * 16384);
    unsigned char* ws = p.ws;
    constexpr int I_G = 16 * 88, I_D = 44 * 32, I_IN = 16 * 85, I_O = 16 * 32, I_UQ = 4 * 12, I_UKV = 2 * 16;
    constexpr int T_G = 4 * I_G, T_U = 4 * I_G, T_D = 4 * I_D, T_IN = 2 * I_IN, T_O = 2 * I_O, T_UQ = 2 * I_UQ, T_UKV = 2 * I_UKV;
    constexpr int NITEMS = T_G + T_U + T_D + T_IN + T_O + T_UQ + T_UKV;
    for (int it = gw; it < NITEMS; it += NGW) {
        int r = it;
        if (r < T_G + T_U) { const bool up = r >= T_G; if (up) r -= T_G; const int mi = r / I_G, q = r % I_G, kb = q / 88, nb = q % 88, n0 = nb * 32;
            const float* W = p.in[up ? 6 : 5] + (size_t)mi * 1024 * 2816; bf16_t* WT = (bf16_t*)(ws + WS_WGU) + (size_t)mi * 5632 * 1024;
            transpose_item(W, 2816, WT, 1024, 0, kb * 64, n0, (n0 / 128) * 256 + (n0 % 128) + (up ? 128 : 0), scr, lane); continue; }
        r -= T_G + T_U;
        if (r < T_D) { const int mi = r / I_D, q = r % I_D, kb = q / 32, nb = q % 32;
            transpose_item(p.in[7] + (size_t)mi * 2816 * 1024, 1024, (bf16_t*)(ws + WS_WDN) + (size_t)mi * 1024 * 2816, 2816, 0, kb * 64, nb * 32, nb * 32, scr, lane); continue; }
        r -= T_D;
        if (r < T_IN) { const int mi = r / I_IN, q = r % I_IN, kb = q / 85, nb = q % 85;
            transpose_item(p.in[8] + (size_t)mi * 1024 * 2720, 2720, (bf16_t*)(ws + WS_WIN) + (size_t)mi * 2816 * 1024, 1024, 0, kb * 64, nb * 32, nb * 32, scr, lane); continue; }
        r -= T_IN;
        if (r < T_O) { const int mi = r / I_O, q = r % I_O, kb = q / 32, nb = q % 32;
            transpose_item(p.in[9] + (size_t)mi * 1024 * 1024, 1024, (bf16_t*)(ws + WS_WOUT) + (size_t)mi * 1024 * 1024, 1024, 0, kb * 64, nb * 32, nb * 32, scr, lane); continue; }
        r -= T_O;
        if (r < T_UQ) { const int mi = r / I_UQ, q = r % I_UQ, kb = q / 12, nb = q % 12;
            transpose_item(p.in[15] + (size_t)mi * 256 * 384, 384, (bf16_t*)(ws + WS_WMLA) + (size_t)mi * 1024 * 384, 384, 0, kb * 64, nb * 32, nb * 32, scr, lane); continue; }
        r -= T_UQ;
        { const int mi = r / I_UKV, q = r % I_UKV, kb = q / 16, nb = q % 16;
            transpose_item(p.in[16] + (size_t)mi * 128 * 512, 512, (bf16_t*)(ws + WS_WMLA) + (size_t)mi * 1024 * 384, 384, 256, kb * 64, nb * 32, 512 + nb * 32, scr, lane); }
    }
    const int gt = gw * 64 + lane, NGT = NGW * 64;
    for (int i = gt; i < 2 * 96 * 128; i += NGT) { const int mi = i / (96 * 128), q = i % (96 * 128), row = 2720 + q / 128, ch = q % 128;
        *(u32x4*)((bf16_t*)(ws + WS_WIN) + (size_t)mi * 2816 * 1024 + (size_t)row * 1024 + ch * 8) = (u32x4){0u, 0u, 0u, 0u}; }
    for (int i = gt; i < 2 * 1024 * 48; i += NGT) { const int mi = i / (1024 * 48), q = i % (1024 * 48), row = q / 48, ch = q % 48;
        const bool z = row < 384 ? (ch >= 32) : (row < 512 ? true : (ch < 32));
        if (z) *(u32x4*)((bf16_t*)(ws + WS_WMLA) + (size_t)mi * 1024 * 384 + (size_t)row * 384 + ch * 8) = (u32x4){0u, 0u, 0u, 0u}; }
    const float L2T = 18.931568569324174f;
    for (int i = gt; i < 8208 * 16; i += NGT) { const int pos = i >> 4, f = i & 15; const float inv = exp2f(-(float)f * (1.0f / 16.0f) * L2T);
        const double rev = (double)pos * (double)inv * 0.15915494309189535; const float fr = (float)(rev - floor(rev));
        ((float*)(ws + WS_TABM))[i] = __builtin_amdgcn_cosf(fr); ((float*)(ws + WS_TABM))[8208 * 16 + i] = __builtin_amdgcn_sinf(fr); }
    for (int i = gt; i < 8208 * 4; i += NGT) { const int pos = i >> 2, f = i & 3; const float inv = exp2f(-(float)f * 0.25f * L2T);
        const double rev = (double)pos * (double)inv * 0.15915494309189535; const float fr = (float)(rev - floor(rev));
        ((float*)(ws + WS_TABD))[i] = __builtin_amdgcn_cosf(fr); ((float*)(ws + WS_TABD))[8208 * 4 + i] = __builtin_amdgcn_sinf(fr); }
    if (gw < 2) { const float* lp = p.in[11] + gw * 128; float a = lane < 32 ? lp[lane] * lp[32 + lane] : 0.f, b = lane < 32 ? lp[64 + lane] * lp[96 + lane] : 0.f;
        a = wave_sum(a); b = wave_sum(b); const float li = 0.8f - 0.6f * expf(-0.3f * (float)gw);
        if (lane == 0) { ((float*)(ws + WS_CTL))[8192 + gw] = expf(a) - expf(b) + li; ((float*)(ws + WS_CTL))[8194 + gw] = li; } }
}

template <int MODE>
DI void norm_rows(const Params& p, const float* g, int gw_, int NGW, int lane_, int r_lo = 0, int r_hi = MP, int wg_lo = 0) {
    const int tid = opaque_tid(), lane = tid & 63, gw = ((int)blockIdx.x - wg_lo) * 8 + __builtin_amdgcn_readfirstlane(tid >> 6);
    bf16_t* XO = (bf16_t*)(p.ws + WS_XO);
    f32x4 gv[4];
#pragma unroll
    for (int j = 0; j < 4; ++j) gv[j] = *(const f32x4*)(g + 4 * lane + 256 * j);
    for (int r0 = r_lo + gw * 4; r0 < r_hi; r0 += NGW * 4) {
        if (r0 >= MR) {
#pragma unroll
            for (int q = 0; q < 4; ++q) { u32x2* o = (u32x2*)(XO + (size_t)(r0 + q) * D) + lane;
#pragma unroll
                for (int j = 0; j < 4; ++j) o[64 * j] = (u32x2){0u, 0u}; }
            continue; }
        f32x4 v[4][4]; float s[4];
#pragma unroll
        for (int q = 0; q < 4; ++q) { const int r = r0 + q;
            const float* src = hrow(p, r);
            if (MODE == 1) src = r < 65536 ? p.in[0] + (size_t)r * D : (r < NREAL ? p.in[1] + (size_t)(r - 65536) * D : p.in[2] + (size_t)((r - NREAL) & 15) * D);
#pragma unroll
            for (int j = 0; j < 4; ++j) v[q][j] = __builtin_nontemporal_load((const f32x4*)(src + 4 * lane + 256 * j)); }
#pragma unroll
        for (int q = 0; q < 4; ++q) { float a = 0.f;
#pragma unroll
            for (int j = 0; j < 4; ++j) a += (v[q][j].x * v[q][j].x + v[q][j].y * v[q][j].y) + (v[q][j].z * v[q][j].z + v[q][j].w * v[q][j].w);
            s[q] = a; }
        if (MODE == 1 && r0 >= NREAL) {
#pragma unroll
            for (int q = 0; q < 4; ++q) { float* hd = hrow(p, r0 + q);
#pragma unroll
                for (int j = 0; j < 4; ++j) *(f32x4*)(hd + 4 * lane + 256 * j) = v[q][j]; } }
#pragma unroll
        for (int o_ = 1; o_ < 64; o_ <<= 1) {
#pragma unroll
            for (int q = 0; q < 4; ++q) s[q] += __shfl_xor(s[q], o_); }
#pragma unroll
        for (int q = 0; q < 4; ++q) { const float rstd = 1.0f / sqrtf(s[q] * (1.0f / D) + EPS); u32x2* o = (u32x2*)(XO + (size_t)(r0 + q) * D) + lane;
#pragma unroll
            for (int j = 0; j < 4; ++j) { const f32x4 y = v[q][j] * rstd * gv[j]; o[64 * j] = (u32x2){cvtpk(y.x, y.y), cvtpk(y.z, y.w)}; } }
    }
}
DI void final_rows(const Params& p, int gw_, int NGW, int lane_) {
    const int tid = opaque_tid(), lane = tid & 63, gw = blockIdx.x * 8 + __builtin_amdgcn_readfirstlane(tid >> 6);
    const float* g = p.in[4];
    f32x4 gv[4];
#pragma unroll
    for (int j = 0; j < 4; ++j) gv[j] = *(const f32x4*)(g + 4 * lane + 256 * j);
    for (int r0 = gw * 4; r0 < NREAL; r0 += NGW * 4) {
        f32x4 v[4][4]; float s[4];
#pragma unroll
        for (int q = 0; q < 4; ++q) { const float* hd = p.out + (size_t)(r0 + q) * D;
#pragma unroll
            for (int j = 0; j < 4; ++j) v[q][j] = *(const f32x4*)(hd + 4 * lane + 256 * j); }
#pragma unroll
        for (int q = 0; q < 4; ++q) { float a = 0.f;
#pragma unroll
            for (int j = 0; j < 4; ++j) a += (v[q][j].x * v[q][j].x + v[q][j].y * v[q][j].y) + (v[q][j].z * v[q][j].z + v[q][j].w * v[q][j].w);
            s[q] = a; }
#pragma unroll
        for (int o_ = 1; o_ < 64; o_ <<= 1) {
#pragma unroll
            for (int q = 0; q < 4; ++q) s[q] += __shfl_xor(s[q], o_); }
#pragma unroll
        for (int q = 0; q < 4; ++q) { const float rstd = 1.0f / sqrtf(s[q] * (1.0f / D) + EPS); float* hd = p.out + (size_t)(r0 + q) * D;
#pragma unroll
            for (int j = 0; j < 4; ++j) __builtin_nontemporal_store(v[q][j] * rstd * gv[j], (f32x4*)(hd + 4 * lane + 256 * j)); }
    }
}
DI void prep_rows(const Params& p, int layer, int gw_, int NGW, int lane_) {
    const int tid = opaque_tid(), lane = tid & 63, gw = blockIdx.x * 8 + __builtin_amdgcn_readfirstlane(tid >> 6);
    bf16_t* U = (bf16_t*)(p.ws + WS_BIG);
    const float* gq = p.in[13] + layer * 256; const float* gkv = p.in[14] + layer * 128;
    const float* tmc = (const float*)(p.ws + WS_TABM); const float* tms = tmc + 8208 * 16;
    const float* tdc = (const float*)(p.ws + WS_TABD); const float* tds = tdc + 8208 * 4;
    const f32x4 gqv = *(const f32x4*)(gq + 4 * lane); const f32x2 gkvv = *(const f32x2*)(gkv + 2 * lane);
    for (int r0 = gw * 4; r0 < MR; r0 += NGW * 4) {
        u32x2 wq[4]; unsigned wk[4], d1[4], d2[4]; f32x2 dc[4], ds[4]; float k1[4], k2[4], kc[4], ks[4];
#pragma unroll
        for (int q = 0; q < 4; ++q) { bf16_t* ur = U + (size_t)(r0 + q) * INP; const int pos = row_pos(r0 + q);
            wq[q] = *(const u32x2*)(ur + U_CQ + 4 * lane); wk[q] = *(const unsigned*)(ur + U_CKV + 2 * lane);
            if (lane < 48) { const bf16_t* cp = ur + U_DAQ + 32 * (lane >> 1) + 2 * (lane & 1); d1[q] = *(const unsigned*)cp; d2[q] = *(const unsigned*)(cp + 4);
                dc[q] = *(const f32x2*)(tdc + pos * 4 + 2 * (lane & 1)); ds[q] = *(const f32x2*)(tds + pos * 4 + 2 * (lane & 1)); }
            else { const int i = lane - 48; const bf16_t* cp = ur + U_KR + i; k1[q] = bf2f(cp[0]); k2[q] = bf2f(cp[16]); kc[q] = tmc[pos * 16 + i]; ks[q] = tms[pos * 16 + i]; } }
        float sq[4], sk[4]; float a[4][4], b[4][2];
#pragma unroll
        for (int q = 0; q < 4; ++q) {
            a[q][0] = __uint_as_float(wq[q].x << 16); a[q][1] = __uint_as_float(wq[q].x & 0xffff0000u); a[q][2] = __uint_as_float(wq[q].y << 16); a[q][3] = __uint_as_float(wq[q].y & 0xffff0000u);
            b[q][0] = __uint_as_float(wk[q] << 16); b[q][1] = __uint_as_float(wk[q] & 0xffff0000u);
            sq[q] = (a[q][0] * a[q][0] + a[q][1] * a[q][1]) + (a[q][2] * a[q][2] + a[q][3] * a[q][3]); sk[q] = b[q][0] * b[q][0] + b[q][1] * b[q][1]; }
#pragma unroll
        for (int o_ = 1; o_ < 64; o_ <<= 1) {
#pragma unroll
            for (int q = 0; q < 4; ++q) { sq[q] += __shfl_xor(sq[q], o_); sk[q] += __shfl_xor(sk[q], o_); } }
#pragma unroll
        for (int q = 0; q < 4; ++q) { bf16_t* ur = U + (size_t)(r0 + q) * INP;
            const float rq = 1.0f / sqrtf(sq[q] * (1.0f / 256.0f) + EPS), rk = 1.0f / sqrtf(sk[q] * (1.0f / 128.0f) + EPS);
            *(u32x2*)(ur + U_CQ + 4 * lane) = (u32x2){cvtpk(a[q][0] * rq * gqv.x, a[q][1] * rq * gqv.y), cvtpk(a[q][2] * rq * gqv.z, a[q][3] * rq * gqv.w)};
            *(unsigned*)(ur + U_CKV + 2 * lane) = cvtpk(b[q][0] * rk * gkvv.x, b[q][1] * rk * gkvv.y);
            if (lane < 48) {
                bf16_t* cp = ur + U_DAQ + 32 * (lane >> 1) + 2 * (lane & 1);
                const float x1a = __uint_as_float(d1[q] << 16), x1b = __uint_as_float(d1[q] & 0xffff0000u), x2a = __uint_as_float(d2[q] << 16), x2b = __uint_as_float(d2[q] & 0xffff0000u);
                *(unsigned*)cp = cvtpk(x1a * dc[q].x - x2a * ds[q].x, x1b * dc[q].y - x2b * ds[q].y);
                *(unsigned*)(cp + 4) = cvtpk(x2a * dc[q].x + x1a * ds[q].x, x2b * dc[q].y + x1b * ds[q].y);
            } else {
                bf16_t* cp = ur + U_KR + (lane - 48);
                const unsigned y = cvtpk(k1[q] * kc[q] - k2[q] * ks[q], k2[q] * kc[q] + k1[q] * ks[q]);
                cp[0] = (bf16_t)(y & 0xffffu); cp[16] = (bf16_t)(y >> 16);
            } }
    }
}

DI float max3f(float a, float b, float c) { float r; asm("v_max3_f32 %0, %1, %2, %3" : "=v"(r) : "v"(a), "v"(b), "v"(c)); return r; }
DI float max2f(float a, float b) { float r; asm("v_max_f32_e32 %0, %1, %2" : "=v"(r) : "v"(a), "v"(b)); return r; }
DI int crow(int r, int hi) { return (r & 3) + 8 * (r >> 2) + 4 * hi; }
DI s16x4 vtr(const LAS unsigned char* p) { typedef short v4i16_t __attribute__((ext_vector_type(4))); return __builtin_bit_cast(s16x4, __builtin_amdgcn_ds_read_tr16_b64_v4i16((LAS v4i16_t*)p)); }

constexpr int FL_STG = 20480, FL_KR = 8192, FL_V = 12288, FL_NST = 3;
constexpr int NA_BIAS_OFF = 131072 + 1024, NA_V_OFF = 65536, NA_V_WAVE = 32 * 192;

template <int NC, int DQK>
DI void flash_unit(LAS unsigned char* lds, const Params& p, int layer, int seq, int h, int qb) {
    constexpr int NS = DQK / 16;
    const bf16_t* U = (const bf16_t*)(p.ws + WS_BIG); const bf16_t* QM = (const bf16_t*)(p.ws + WS_QKVM); bf16_t* XO = (bf16_t*)(p.ws + WS_XO);
    const int tid = opaque_tid(), lane = tid & 63, r32 = lane & 31, hi = lane >> 5, wid = __builtin_amdgcn_readfirstlane(tid >> 6);
    const int Treal = seq < 8 ? 8192 : 2048, rbase = seq < 8 ? seq * 8192 : 65536 + (seq - 8) * 2048, mbase = METAB + 16 * seq;
    const int nqb = Treal / 256, NT = Treal / 64 + 1;
    const bool metaq = (qb >= nqb);
    const int qrow = metaq ? mbase + (r32 & 15) : rbase + 256 * qb + 32 * wid + r32;
    const bool valid = metaq ? (wid == 0 && r32 < 16) : true;
    bf16x8 qf[NC][NS];
#pragma unroll
    for (int c = 0; c < NC; ++c)
#pragma unroll
        for (int s = 0; s < NS; ++s) {
            const bf16_t* src = (NC == 2) ? U + (size_t)qrow * INP + U_DAQ + 64 * h + c * DQK + 16 * s + 8 * hi : QM + (size_t)qrow * 1024 + 96 * h + 16 * s + 8 * hi;
            qf[c][s] = *(const bf16x8*)src; }
    if (NC == 1) {
        const float* tc = (const float*)(p.ws + WS_TABM) + row_pos(qrow) * 16 + 8 * hi; const float* tsn = tc + 8208 * 16;
        const f32x4 c0 = *(const f32x4*)tc, c1 = *(const f32x4*)(tc + 4), s0 = *(const f32x4*)tsn, s1 = *(const f32x4*)(tsn + 4);
        const u32x4 a = __builtin_bit_cast(u32x4, qf[0][NS - 2]), b = __builtin_bit_cast(u32x4, qf[0][NS - 1]); u32x4 ra, rb;
#pragma unroll
        for (int w = 0; w < 4; ++w) { const float cl = w < 2 ? c0[2 * w] : c1[2 * w - 4], ch = w < 2 ? c0[2 * w + 1] : c1[2 * w - 3], sl = w < 2 ? s0[2 * w] : s1[2 * w - 4], sh = w < 2 ? s0[2 * w + 1] : s1[2 * w - 3];
            const float x1l = __uint_as_float(a[w] << 16), x1h = __uint_as_float(a[w] & 0xffff0000u), x2l = __uint_as_float(b[w] << 16), x2h = __uint_as_float(b[w] & 0xffff0000u);
            ra[w] = cvtpk(x1l * cl - x2l * sl, x1h * ch - x2h * sh); rb[w] = cvtpk(x2l * cl + x1l * sl, x2h * ch + x1h * sh); }
        qf[0][NS - 2] = __builtin_bit_cast(bf16x8, ra); qf[0][NS - 1] = __builtin_bit_cast(bf16x8, rb);
    }
    const float sc = (NC == 2 ? 0.17677669529663687f : 0.10206207261596575f) * 1.4426950408889634f;
#pragma unroll
    for (int c = 0; c < NC; ++c)
#pragma unroll
        for (int s = 0; s < NS; ++s) { const u32x4 a = __builtin_bit_cast(u32x4, qf[c][s]); u32x4 ra;
#pragma unroll
            for (int w = 0; w < 4; ++w) ra[w] = cvtpk(__uint_as_float(a[w] << 16) * sc, __uint_as_float(a[w] & 0xffff0000u) * sc);
            qf[c][s] = __builtin_bit_cast(bf16x8, ra); }
    const unsigned ldsb = (unsigned)(uintptr_t)lds;
    const int drow = 8 * wid + (lane >> 3), dcp = lane & 7;
    const int KPITCH = (NC == 2) ? INP * 2 : 2048;
    const unsigned kvoff = (unsigned)(drow * KPITCH + ((dcp ^ ((drow >> 1) & 7)) * 16));
    const unsigned vvoff = (unsigned)(drow * KPITCH + ((dcp ^ (((drow >> 1) & 1) << 2)) * 16));
    const int rrow = 8 * wid + ((lane & 31) >> 2), rcp = lane & 3;
    const unsigned rvoff = (unsigned)(rrow * (INP * 2) + ((rcp ^ ((rrow >> 2) & 3)) * 16));
    const char* kbase0 = (NC == 2) ? (const char*)(U + U_DAK + 64 * h) : (const char*)(QM + 512 + 128 * h);
    const char* vbase0 = (NC == 2) ? (const char*)(U + U_DAV + 64 * h) : (const char*)(QM + 512 + 128 * h + 64);
    const char* rbase0 = (const char*)(U + U_KR);
    auto dma_tile = [&](int t, int slot) {
        const int tt = t < NT ? t : NT - 1;
        const size_t kr = (size_t)(tt == 0 ? mbase : rbase + 64 * (tt - 1));
        const unsigned dst = ldsb + (unsigned)(slot * FL_STG) + (unsigned)wid * 1024u;
        pg8::glds16s(kbase0 + kr * KPITCH, kvoff, dst);
        pg8::glds16s(vbase0 + kr * KPITCH, vvoff, dst + FL_V);
        if (NC == 1) { if (lane < 32) pg8::glds16s(rbase0 + kr * (INP * 2), rvoff, ldsb + (unsigned)(slot * FL_STG) + FL_KR + (unsigned)wid * 512u); }
    };
    float mrun[NC], lrun[NC]; f32x16 o[NC][2];
    f32x16 negm[NC];
#pragma unroll
    for (int c = 0; c < NC; ++c) { mrun[c] = 0.f; lrun[c] = 0.f;
#pragma unroll
        for (int r = 0; r < 16; ++r) negm[c][r] = 0.f;
#pragma unroll
        for (int c2 = 0; c2 < 2; ++c2)
#pragma unroll
            for (int r = 0; r < 16; ++r) o[c][c2][r] = 0.f; }
    dma_tile(0, 0); dma_tile(1, 1);
    const int ksw = (r32 >> 1) & 7;
    int koffs[NC * 2 > 4 ? NC * 2 : 4];
#pragma unroll
    for (int i = 0; i < 4; ++i) koffs[i] = r32 * 128 + (((2 * i + hi) ^ ksw) * 16);
    const int rsw = (r32 >> 2) & 3;
    int roffs[2];
#pragma unroll
    for (int i = 0; i < 2; ++i) roffs[i] = FL_KR + r32 * 64 + (((2 * i + hi) ^ rsw) * 16);
    const int vq = (lane & 15) >> 2, vp = lane & 3, vblk = (lane >> 4) & 1;
    int voffs[2];
#pragma unroll
    for (int c2 = 0; c2 < 2; ++c2) voffs[c2] = FL_V + (4 * hi + vq) * 128 + ((c2 ^ ((vq >> 1) & 1)) * 64) + (2 * vblk + (vp >> 1)) * 16 + 8 * (vp & 1);
    int slot = 0;
    for (int t = 0; t < NT; ++t) {
        if (NC == 2) asm volatile("s_waitcnt vmcnt(2)\n\ts_barrier" ::: "memory"); else asm volatile("s_waitcnt vmcnt(3)\n\ts_barrier" ::: "memory");
        { int s2 = slot + 2; if (s2 >= FL_NST) s2 -= FL_NST; dma_tile(t + 2, s2); }
        const LAS unsigned char* kb = lds + slot * FL_STG;
        const LAS unsigned char* vb = kb;
        slot = (slot + 1 == FL_NST) ? 0 : slot + 1;
        bf16x8 pb[NC][2][2];
        bf16x8 vf[2][2][2];
#pragma unroll
        for (int c = 0; c < NC; ++c) {
            bf16x8 ka[NS][2];
#pragma unroll
            for (int s = 0; s < NS; ++s) {
                const int ko = (NC == 2) ? koffs[2 * c + s] : (s < 4 ? koffs[s < 4 ? s : 0] : roffs[s >= 4 ? s - 4 : 0]);
                const int kstep32 = (NC == 1 && s >= 4) ? 32 * 64 : 32 * 128;
                ka[s][0] = *(const LAS bf16x8*)(kb + ko);
                ka[s][1] = *(const LAS bf16x8*)(kb + ko + kstep32); }
            __builtin_amdgcn_sched_barrier(0);
            f32x16 s0 = negm[c], s1 = negm[c];
#pragma unroll
            for (int s = 0; s < NS; ++s) {
                s0 = __builtin_amdgcn_mfma_f32_32x32x16_bf16(ka[s][0], qf[c][s], s0, 0, 0, 0);
                s1 = __builtin_amdgcn_mfma_f32_32x32x16_bf16(ka[s][1], qf[c][s], s1, 0, 0, 0); }
            if (NC == 1) {
#pragma unroll
                for (int c2 = 0; c2 < 2; ++c2)
#pragma unroll
                    for (int kh = 0; kh < 2; ++kh)
#pragma unroll
                        for (int s2 = 0; s2 < 2; ++s2) {
                            const LAS unsigned char* vp = vb + voffs[c2] + (32 * kh + 16 * s2) * 128;
                            const s16x4 lo = vtr(vp), hh = vtr(vp + 8 * 128);
                            vf[c2][kh][s2] = (bf16x8){lo[0], lo[1], lo[2], lo[3], hh[0], hh[1], hh[2], hh[3]}; }
            }
            __builtin_amdgcn_sched_barrier(0);
            asm volatile("s_nop 15\n\ts_nop 7" : "+v"(s0), "+v"(s1));
            if (t == 0) {
#pragma unroll
                for (int r = 0; r < 16; ++r) { if (r >= 8) s0[r] = -INFINITY; s1[r] = -INFINITY; } }
            float ra = max3f(s0[0], s0[1], s1[0]), rb = max3f(s0[2], s0[3], s1[1]); ra = max3f(ra, s1[2], s1[3]);
#pragma unroll
            for (int r = 4; r < 16; r += 4) { ra = max3f(ra, s0[r], s0[r + 1]); rb = max3f(rb, s0[r + 2], s0[r + 3]); ra = max3f(ra, s1[r], s1[r + 1]); rb = max3f(rb, s1[r + 2], s1[r + 3]); }
            float rm = max2f(ra, rb);
            { auto rr = __builtin_amdgcn_permlane32_swap(__float_as_uint(rm), __float_as_uint(rm), false, false); rm = max2f(__uint_as_float(rr[0]), __uint_as_float(rr[1])); }
            if (t == 0 || __any(rm > 8.0f)) {
                const float delta = (t == 0) ? rm : max2f(rm, 0.f);
                const float alpha = (t == 0) ? 1.0f : __builtin_amdgcn_exp2f(-delta);
                mrun[c] += delta; lrun[c] *= alpha;
#pragma unroll
                for (int c2 = 0; c2 < 2; ++c2)
#pragma unroll
                    for (int r = 0; r < 16; ++r) o[c][c2][r] *= alpha;
#pragma unroll
                for (int r = 0; r < 16; ++r) { s0[r] -= delta; s1[r] -= delta; negm[c][r] = -mrun[c]; } }
#pragma unroll
            for (int r = 0; r < 16; ++r) { s0[r] = __builtin_amdgcn_exp2f(s0[r]); s1[r] = __builtin_amdgcn_exp2f(s1[r]); }
            f32x2 la = {0.f, 0.f}, lb = {0.f, 0.f};
#pragma unroll
            for (int r = 0; r < 16; r += 2) { la += (f32x2){s0[r], s0[r + 1]}; lb += (f32x2){s1[r], s1[r + 1]}; }
            la += lb; lrun[c] += la.x + la.y;
#pragma unroll
            for (int s2 = 0; s2 < 2; ++s2) {
                u32x4 w0, w1;
                w0.x = cvtpk(s0[8 * s2 + 0], s0[8 * s2 + 1]); w0.y = cvtpk(s0[8 * s2 + 2], s0[8 * s2 + 3]); w0.z = cvtpk(s0[8 * s2 + 4], s0[8 * s2 + 5]); w0.w = cvtpk(s0[8 * s2 + 6], s0[8 * s2 + 7]);
                w1.x = cvtpk(s1[8 * s2 + 0], s1[8 * s2 + 1]); w1.y = cvtpk(s1[8 * s2 + 2], s1[8 * s2 + 3]); w1.z = cvtpk(s1[8 * s2 + 4], s1[8 * s2 + 5]); w1.w = cvtpk(s1[8 * s2 + 6], s1[8 * s2 + 7]);
                pb[c][0][s2] = __builtin_bit_cast(bf16x8, w0); pb[c][1][s2] = __builtin_bit_cast(bf16x8, w1); }
        }
#pragma unroll
        for (int kh = 0; kh < 2; ++kh)
#pragma unroll
            for (int s2 = 0; s2 < 2; ++s2)
#pragma unroll
                for (int c2 = 0; c2 < 2; ++c2) {
                    bf16x8 va;
                    if (NC == 1) va = vf[c2][kh][s2];
                    else { const LAS unsigned char* vp = vb + voffs[c2] + (32 * kh + 16 * s2) * 128;
                        const s16x4 lo = vtr(vp), hh = vtr(vp + 8 * 128);
                        va = (bf16x8){lo[0], lo[1], lo[2], lo[3], hh[0], hh[1], hh[2], hh[3]}; }
#pragma unroll
                    for (int c = 0; c < NC; ++c) o[c][c2] = __builtin_amdgcn_mfma_f32_32x32x16_bf16(va, pb[c][kh][s2], o[c][c2], 0, 0, 0);
                }
    }
    asm volatile("s_waitcnt vmcnt(0)" ::: "memory");
    float inv[NC];
#pragma unroll
    for (int c = 0; c < NC; ++c) inv[c] = 1.0f / swapsum(lrun[c]);
    if (NC == 2) {
        const float lam = ((const float*)(p.ws + WS_CTL))[8192 + layer], li = ((const float*)(p.ws + WS_CTL))[8194 + layer];
        float ss = 0.f;
#pragma unroll
        for (int c2 = 0; c2 < 2; ++c2)
#pragma unroll
            for (int r = 0; r < 16; ++r) { const float v = o[0][c2][r] * inv[0] - lam * (o[NC - 1][c2][r] * inv[NC - 1]); o[0][c2][r] = v; ss += v * v; }
        ss = swapsum(ss);
        const float rs = (1.0f - li) / sqrtf(ss * (1.0f / 64.0f) + EPS);
        const float* sg = p.in[12] + layer * 64;
        bf16_t* dst = XO + (size_t)qrow * 1024 + 384 + 64 * h;
        if (valid) {
#pragma unroll
            for (int c2 = 0; c2 < 2; ++c2)
#pragma unroll
                for (int g4 = 0; g4 < 4; ++g4) { const int dv0 = 32 * c2 + 8 * g4 + 4 * hi; const f32x4 gg = *(const f32x4*)(sg + dv0);
                    *(u32x2*)(dst + dv0) = (u32x2){cvtpk(o[0][c2][4 * g4] * rs * gg.x, o[0][c2][4 * g4 + 1] * rs * gg.y), cvtpk(o[0][c2][4 * g4 + 2] * rs * gg.z, o[0][c2][4 * g4 + 3] * rs * gg.w)}; }
        }
    } else {
        bf16_t* dst = XO + (size_t)qrow * 1024 + 768 + 64 * h;
        if (valid) {
#pragma unroll
            for (int c2 = 0; c2 < 2; ++c2)
#pragma unroll
                for (int g4 = 0; g4 < 4; ++g4) { const int dv0 = 32 * c2 + 8 * g4 + 4 * hi; const float iv = inv[0];
                    *(u32x2*)(dst + dv0) = (u32x2){cvtpk(o[0][c2][4 * g4] * iv, o[0][c2][4 * g4 + 1] * iv), cvtpk(o[0][c2][4 * g4 + 2] * iv, o[0][c2][4 * g4 + 3] * iv)}; }
        }
    }
}

DI void na_task(LAS unsigned char* wv, const LAS float* btab, const Params& p, int seq, int r, int rows, int cb, int h, bool metaq) {
    const bf16_t* U = (const bf16_t*)(p.ws + WS_BIG); bf16_t* XO = (bf16_t*)(p.ws + WS_XO);
    const int lane = opaque_tid() & 63, m16 = lane & 15, kg = lane >> 4;
    const int rbase = seq < 8 ? seq * 8192 : 65536 + (seq - 8) * 2048, mbase = METAB + 16 * seq;
    const int qrow = metaq ? mbase + m16 : rbase + r * 64 + 16 * cb + m16;
    bf16x8 qf[2];
#pragma unroll
    for (int s = 0; s < 2; ++s) qf[s] = *(const bf16x8*)(U + (size_t)qrow * INP + U_NAQ + 64 * h + 32 * s + 8 * kg);
    int rs = r - 4; rs = rs < 0 ? 0 : (rs > rows - 8 ? rows - 8 : rs);
    const int kc0 = cb == 0 ? 0 : (cb == 1 ? 8 : (cb == 2 ? 24 : 32));
    const int qc = 16 * cb + m16; int wsq = qc - 8; wsq = wsq < 0 ? 0 : (wsq > 48 ? 48 : wsq);
    f32x4 sc[17];
    const f32x4 z4 = {0.f, 0.f, 0.f, 0.f};
    { const bf16_t* kp = U + (size_t)(mbase + m16) * INP + U_NAK + 64 * h + 8 * kg;
      f32x4 a = __builtin_amdgcn_mfma_f32_16x16x32_bf16(*(const bf16x8*)kp, qf[0], z4, 0, 0, 0);
      a = __builtin_amdgcn_mfma_f32_16x16x32_bf16(*(const bf16x8*)(kp + 32), qf[1], a, 0, 0, 0);
      sc[16] = a * 0.125f; }
#pragma unroll
    for (int i = 0; i < 16; ++i) sc[i] = (f32x4){-INFINITY, -INFINITY, -INFINITY, -INFINITY};
    if (!metaq) {
#pragma unroll
        for (int w = 0; w < 8; ++w)
#pragma unroll
            for (int hf = 0; hf < 2; ++hf) {
                const bf16_t* kp = U + (size_t)(rbase + (rs + w) * 64 + kc0 + 16 * hf + m16) * INP + U_NAK + 64 * h + 8 * kg;
                f32x4 a = __builtin_amdgcn_mfma_f32_16x16x32_bf16(*(const bf16x8*)kp, qf[0], z4, 0, 0, 0);
                a = __builtin_amdgcn_mfma_f32_16x16x32_bf16(*(const bf16x8*)(kp + 32), qf[1], a, 0, 0, 0);
                const LAS float* brow = btab + h * 465 + (rs + w - r + 7) * 31;
#pragma unroll
                for (int j = 0; j < 4; ++j) { const int kc = kc0 + 16 * hf + 4 * kg + j; const bool ok = (kc >= wsq) && (kc < wsq + 16);
                    int bi = kc - qc + 15; bi = bi < 0 ? 0 : (bi > 30 ? 30 : bi);
                    a[j] = ok ? a[j] * 0.125f + brow[bi] : -INFINITY; }
                sc[2 * w + hf] = a; }
    }
    float mx = -INFINITY;
#pragma unroll
    for (int i = 0; i < 17; ++i) mx = fmaxf(mx, fmaxf(fmaxf(sc[i][0], sc[i][1]), fmaxf(sc[i][2], sc[i][3])));
    mx = fmaxf(mx, __shfl_xor(mx, 16)); mx = fmaxf(mx, __shfl_xor(mx, 32));
    float sum = 0.f;
#pragma unroll
    for (int i = 0; i < 17; ++i)
#pragma unroll
        for (int j = 0; j < 4; ++j) { const float e = __builtin_amdgcn_exp2f((sc[i][j] - mx) * 1.4426950408889634f); sc[i][j] = e; sum += e; }
    sum += __shfl_xor(sum, 16); sum += __shfl_xor(sum, 32);
    f32x4 o4[4] = {z4, z4, z4, z4};
    const int vl = (4 * kg + ((lane & 15) >> 2)) * 192 + 8 * (lane & 3);
    auto chunk = [&](int vrow0, const f32x4& pa, const f32x4& pbv) {
#pragma unroll
        for (int i = 0; i < 4; ++i) { const int row = (lane >> 3) + 8 * i, ch = lane & 7;
            const u32x4 v = *(const u32x4*)(U + (size_t)(vrow0 + row) * INP + U_NAV + 64 * h + 8 * ch);
            *(LAS u32x4*)(wv + row * 192 + 16 * ch) = v; }
        u32x4 w; w.x = cvtpk(pa[0], pa[1]); w.y = cvtpk(pa[2], pa[3]); w.z = cvtpk(pbv[0], pbv[1]); w.w = cvtpk(pbv[2], pbv[3]);
        const bf16x8 bfr = __builtin_bit_cast(bf16x8, w);
#pragma unroll
        for (int c = 0; c < 4; ++c) { const s16x4 lo = vtr(wv + vl + 32 * c), hh = vtr(wv + vl + 16 * 192 + 32 * c);
            const bf16x8 va = (bf16x8){lo[0], lo[1], lo[2], lo[3], hh[0], hh[1], hh[2], hh[3]};
            o4[c] = __builtin_amdgcn_mfma_f32_16x16x32_bf16(va, bfr, o4[c], 0, 0, 0); }
    };
    chunk(mbase, sc[16], z4);
    if (!metaq) {
#pragma unroll
        for (int w = 0; w < 8; ++w) chunk(rbase + (rs + w) * 64 + kc0, sc[2 * w], sc[2 * w + 1]);
    }
    const float iv = 1.0f / sum;
    bf16_t* dst = XO + (size_t)qrow * 1024 + 64 * h + 4 * kg;
#pragma unroll
    for (int c = 0; c < 4; ++c) *(u32x2*)(dst + 16 * c) = (u32x2){cvtpk(o4[c][0] * iv, o4[c][1] * iv), cvtpk(o4[c][2] * iv, o4[c][3] * iv)};
}

DI void na_task_fast(LAS unsigned char* wv, const LAS float* btab, const Params& p, int seq, int r, int rows, int cb, int h) {
    const bf16_t* U = (const bf16_t*)(p.ws + WS_BIG); bf16_t* XO = (bf16_t*)(p.ws + WS_XO);
    const int lane = opaque_tid() & 63, m16 = lane & 15, kg = lane >> 4;
    const int rbase = seq < 8 ? seq * 8192 : 65536 + (seq - 8) * 2048, mbase = METAB + 16 * seq;
    const int qrow = rbase + r * 64 + 16 * cb + m16;
    bf16x8 qf[2];
#pragma unroll
    for (int s = 0; s < 2; ++s) qf[s] = *(const bf16x8*)(U + (size_t)qrow * INP + U_NAQ + 64 * h + 32 * s + 8 * kg);
    int rs = r - 4; rs = rs < 0 ? 0 : (rs > rows - 8 ? rows - 8 : rs);
    const int kc0 = cb == 0 ? 0 : (cb == 1 ? 8 : (cb == 2 ? 24 : 32));
    const int qc = 16 * cb + m16; int wsq = qc - 8; wsq = wsq < 0 ? 0 : (wsq > 48 ? 48 : wsq);
    const f32x4 z4 = {0.f, 0.f, 0.f, 0.f};
    f32x4 sc[17];
    const bf16_t* kbase = U + (size_t)(rbase + rs * 64 + kc0 + m16) * INP + U_NAK + 64 * h + 8 * kg;
    const bf16_t* vbase = U + (size_t)(rbase + rs * 64 + kc0 + (lane >> 3)) * INP + U_NAV + 64 * h + 8 * (lane & 7);
    const bf16_t* vmeta = U + (size_t)(mbase + (lane >> 3)) * INP + U_NAV + 64 * h + 8 * (lane & 7);
    const LAS float* bbase = btab + h * 465 + (rs - r + 7) * 31 + (kc0 + 4 * kg - qc + 15);
    bool okm[2][4];
#pragma unroll
    for (int hf = 0; hf < 2; ++hf)
#pragma unroll
        for (int j = 0; j < 4; ++j) { const int kcx = kc0 + 16 * hf + 4 * kg + j; okm[hf][j] = (kcx >= wsq) && (kcx < wsq + 16); }
    bf16x8 km[2], ka[4][2], kb[4][2], kc[4][2];
#define NA_KLOAD(K, B) _Pragma("unroll") for (int i_ = 0; i_ < 4; ++i_) { const bf16_t* kp_ = kbase + (size_t)((((B) * 4 + i_) >> 1) * 64 + 16 * (i_ & 1)) * INP; K[i_][0] = *(const bf16x8*)kp_; K[i_][1] = *(const bf16x8*)(kp_ + 32); }
#define NA_KCOMP(K, B) _Pragma("unroll") for (int i_ = 0; i_ < 4; ++i_) { const int w_ = ((B) * 4 + i_) >> 1, hf_ = i_ & 1; \
        f32x4 a_ = __builtin_amdgcn_mfma_f32_16x16x32_bf16(K[i_][0], qf[0], z4, 0, 0, 0); a_ = __builtin_amdgcn_mfma_f32_16x16x32_bf16(K[i_][1], qf[1], a_, 0, 0, 0); \
        _Pragma("unroll") for (int j_ = 0; j_ < 4; ++j_) a_[j_] = okm[hf_][j_] ? __builtin_fmaf(a_[j_], 0.125f, bbase[w_ * 31 + 16 * hf_ + j_]) : -INFINITY; \
        sc[(B) * 4 + i_] = a_; }
    { const bf16_t* kp = U + (size_t)(mbase + m16) * INP + U_NAK + 64 * h + 8 * kg; km[0] = *(const bf16x8*)kp; km[1] = *(const bf16x8*)(kp + 32); }
    NA_KLOAD(ka, 0); NA_KLOAD(kb, 1); NA_KLOAD(kc, 2);
    __builtin_amdgcn_sched_barrier(0);
    { f32x4 a = __builtin_amdgcn_mfma_f32_16x16x32_bf16(km[0], qf[0], z4, 0, 0, 0); a = __builtin_amdgcn_mfma_f32_16x16x32_bf16(km[1], qf[1], a, 0, 0, 0); sc[16] = a * 0.125f; }
    NA_KCOMP(ka, 0); NA_KLOAD(ka, 3);
    __builtin_amdgcn_sched_barrier(0);
    NA_KCOMP(kb, 1);
    __builtin_amdgcn_sched_barrier(0);
    u32x4 pre[3][4];
#define NA_VLOAD(S, C) _Pragma("unroll") for (int i_ = 0; i_ < 4; ++i_) pre[S][i_] = *(const u32x4*)(((C) == 0 ? vmeta : vbase + (size_t)(((C) - 1) * 64) * INP) + (size_t)(8 * i_) * INP);
    NA_VLOAD(0, 0); NA_VLOAD(1, 1);
    __builtin_amdgcn_sched_barrier(0);
    NA_KCOMP(kc, 2);
    __builtin_amdgcn_sched_barrier(0);
    NA_KCOMP(ka, 3);
    float mx = -INFINITY;
#pragma unroll
    for (int i = 0; i < 17; ++i) mx = fmaxf(mx, fmaxf(fmaxf(sc[i][0], sc[i][1]), fmaxf(sc[i][2], sc[i][3])));
    mx = fmaxf(mx, __shfl_xor(mx, 16)); mx = fmaxf(mx, __shfl_xor(mx, 32));
    float sum = 0.f;
#pragma unroll
    for (int i = 0; i < 17; ++i)
#pragma unroll
        for (int j = 0; j < 4; ++j) { const float e = __builtin_amdgcn_exp2f((sc[i][j] - mx) * 1.4426950408889634f); sc[i][j] = e; sum += e; }
    sum += __shfl_xor(sum, 16); sum += __shfl_xor(sum, 32);
    f32x4 o4[4] = {z4, z4, z4, z4};
    const int vl = (4 * kg + ((lane & 15) >> 2)) * 192 + 8 * (lane & 3);
    const int wrow = (lane >> 3) * 192 + 16 * (lane & 7);
#define NA_VUSE(S, PA, PB) { _Pragma("unroll") for (int i_ = 0; i_ < 4; ++i_) *(LAS u32x4*)(wv + wrow + 8 * i_ * 192) = pre[S][i_]; \
        u32x4 w_; w_.x = cvtpk(PA[0], PA[1]); w_.y = cvtpk(PA[2], PA[3]); w_.z = cvtpk(PB[0], PB[1]); w_.w = cvtpk(PB[2], PB[3]); const bf16x8 bfr_ = __builtin_bit_cast(bf16x8, w_); \
        _Pragma("unroll") for (int c_ = 0; c_ < 4; ++c_) { const s16x4 lo_ = vtr(wv + vl + 32 * c_), hh_ = vtr(wv + vl + 16 * 192 + 32 * c_); \
            const bf16x8 va_ = (bf16x8){lo_[0], lo_[1], lo_[2], lo_[3], hh_[0], hh_[1], hh_[2], hh_[3]}; o4[c_] = __builtin_amdgcn_mfma_f32_16x16x32_bf16(va_, bfr_, o4[c_], 0, 0, 0); } }
    NA_VLOAD(2, 2); __builtin_amdgcn_sched_barrier(0);
    NA_VUSE(0, sc[16], z4);      NA_VLOAD(0, 3); __builtin_amdgcn_sched_barrier(0);
    NA_VUSE(1, sc[0], sc[1]);    NA_VLOAD(1, 4); __builtin_amdgcn_sched_barrier(0);
    NA_VUSE(2, sc[2], sc[3]);    NA_VLOAD(2, 5); __builtin_amdgcn_sched_barrier(0);
    NA_VUSE(0, sc[4], sc[5]);    NA_VLOAD(0, 6); __builtin_amdgcn_sched_barrier(0);
    NA_VUSE(1, sc[6], sc[7]);    NA_VLOAD(1, 7); __builtin_amdgcn_sched_barrier(0);
    NA_VUSE(2, sc[8], sc[9]);    NA_VLOAD(2, 8); __builtin_amdgcn_sched_barrier(0);
    NA_VUSE(0, sc[10], sc[11]);  __builtin_amdgcn_sched_barrier(0);
    NA_VUSE(1, sc[12], sc[13]);  __builtin_amdgcn_sched_barrier(0);
    NA_VUSE(2, sc[14], sc[15]);
#undef NA_KLOAD
#undef NA_KCOMP
#undef NA_VLOAD
#undef NA_VUSE
    const float iv = 1.0f / sum;
    bf16_t* dst = XO + (size_t)qrow * 1024 + 64 * h + 4 * kg;
#pragma unroll
    for (int c = 0; c < 4; ++c) *(u32x2*)(dst + 16 * c) = (u32x2){cvtpk(o4[c][0] * iv, o4[c][1] * iv), cvtpk(o4[c][2] * iv, o4[c][3] * iv)};
}

constexpr int Q_DAP = 8 * 6 * 33, Q_MLP = 8 * 4 * 33, Q_DAS = 16 * 6 * 9, Q_MLS = 16 * 4 * 9, Q_NA = 1536, Q_NAM = 24;
constexpr int Q_TOTAL = Q_DAP + Q_MLP + Q_DAS + Q_MLS + Q_NA + Q_NAM;
constexpr int QX_DAP = Q_DAP / 8, QX_MLP = Q_MLP / 8, QX_DAS = Q_DAS / 8, QX_MLS = Q_MLS / 8, QX_NA = Q_NA / 8, QX_NAM = Q_NAM / 8, QX_TOTAL = Q_TOTAL / 8;

DI void attn_phase(LAS unsigned char* lds, const Params& p, int layer, int ctr_idx, int only = 7) {
    const int tid = opaque_tid(), wave = __builtin_amdgcn_readfirstlane(tid >> 6);
    LAS float* btab = (LAS float*)(lds + NA_BIAS_OFF);
    const float* bsrc = p.in[10] + layer * 2790;
    for (int i = tid; i < 2790; i += 512) btab[i] = bsrc[i];
    volatile LAS unsigned* slot = (volatile LAS unsigned*)(lds + 131072);
    const int xcc = (int)(__builtin_amdgcn_s_getreg((3 << 11) | 20) & 7u);
#pragma unroll 1
    for (int qi = 0; qi < 8; ++qi) {
        const int x = (xcc + qi) & 7;
        unsigned* ctr = (unsigned*)(p.ws + WS_CTL) + 64 * (ctr_idx * 8 + x);
        for (;;) {
            __syncthreads();
            if (tid == 0) *slot = atomicAdd(ctr, 1u);
            __syncthreads();
            int idx = (int)*slot;
            if (idx >= QX_TOTAL) break;
#ifndef NO_DA
            if (idx < QX_DAP) { if (!(only & 1) || (layer == 1 && idx % 33 == 32)) continue; const int pair = x * 6 + idx / 33; flash_unit<2, 32>(lds, p, layer, pair / 6, pair % 6, idx % 33); continue; }
#endif
            idx -= QX_DAP;
#ifndef NO_MLA
            if (idx < QX_MLP) { if (!(only & 2) || (layer == 1 && idx % 33 == 32)) continue; const int pair = x * 4 + idx / 33; flash_unit<1, 96>(lds, p, layer, pair / 4, pair % 4, idx % 33); continue; }
#endif
            idx -= QX_MLP;
#ifndef NO_DA
            if (idx < QX_DAS) { if (!(only & 1) || (layer == 1 && idx % 9 == 8)) continue; const int pair = x * 12 + idx / 9; flash_unit<2, 32>(lds, p, layer, 8 + pair / 6, pair % 6, idx % 9); continue; }
#endif
            idx -= QX_DAS;
#ifndef NO_MLA
            if (idx < QX_MLS) { if (!(only & 2) || (layer == 1 && idx % 9 == 8)) continue; const int pair = x * 8 + idx / 9; flash_unit<1, 96>(lds, p, layer, 8 + pair / 4, pair % 4, idx % 9); continue; }
#endif
            idx -= QX_MLS;
            if (!(only & 4)) continue;
#ifndef NO_NA
            LAS unsigned char* wv = lds + NA_V_OFF + wave * NA_V_WAVE;
            if (idx < QX_NA) {
                const int gr = x * QX_NA + idx;
                int seq, r, rows;
                if (gr < 1024) { seq = gr >> 7; r = gr & 127; rows = 128; } else { seq = 8 + ((gr - 1024) >> 5); r = (gr - 1024) & 31; rows = 32; }
#pragma unroll 1
                for (int i = 0; i < 3; ++i) { const int id = wave + 8 * i; na_task_fast(wv, btab, p, seq, r, rows, id & 3, id >> 2); }
                continue; }
            idx -= QX_NA;
            if (layer == 0 && wave < 6) na_task(wv, btab, p, x * 3 + idx, 0, 8, 0, wave, true);
#endif
        }
    }
}

#define RLX_AGENT __ATOMIC_RELAXED, __HIP_MEMORY_SCOPE_AGENT
#define XB_TMO      128
#define XB_XCNT(j)  (256  + 64 * (j))
#define XB_XSUB(j)  (1280 + 64 * (j))
#define XB_XGEN(j)  (2304 + 64 * (j))
#define XB_TOP      3328
#define XB_TOPGEN   3392
#define XCD_BAR_WORDS 3456
#define XB_SPIN_CAP (1u << 18)

__device__ __forceinline__ unsigned xb_ld(unsigned* p)              { return __hip_atomic_load(p, __ATOMIC_RELAXED, __HIP_MEMORY_SCOPE_AGENT); }
__device__ __forceinline__ unsigned xb_add(unsigned* p, unsigned v) { return __hip_atomic_fetch_add(p, v, __ATOMIC_RELAXED, __HIP_MEMORY_SCOPE_AGENT); }
__device__ __forceinline__ unsigned xb_xcc_id() { return (unsigned)__builtin_amdgcn_s_getreg((3 << 11) | 20) & 0xFu; }
#define XB_SPIN(cond, bar) do { unsigned _sp = 0; while (cond) { __builtin_amdgcn_s_sleep(1); \
    if ((++_sp & 255u) == 0u) { if (xb_ld(&(bar)[XB_TMO])) break; if (_sp > XB_SPIN_CAP) { atomicAdd(&(bar)[XB_TMO], 1u); break; } } } } while (0)

struct XcdBarrier {
    unsigned* bar; unsigned x;
    volatile LAS unsigned* st;
};

__device__ __forceinline__ XcdBarrier xcd_barrier_post(unsigned* bar, volatile LAS unsigned* st) {
    XcdBarrier b; b.bar = bar; b.x = xb_xcc_id(); b.st = st;
    if (threadIdx.x == 0) (void)xb_add(&bar[XB_XCNT(b.x)], 1u);
    return b;
}
__device__ __forceinline__ void xcd_barrier_complete(unsigned* bar, unsigned x, unsigned& nloc, unsigned& nx) {
    const unsigned G = gridDim.x * gridDim.y * gridDim.z;
    unsigned sum, cnt, mine, sp = 0u;
    for (;;) {
        sum = 0u; cnt = 0u; mine = 0u;
#pragma unroll
        for (unsigned j = 0; j < 16; ++j) { const unsigned c = xb_ld(&bar[XB_XCNT(j)]); sum += c; cnt += (c > 0u) ? 1u : 0u; mine = (j == x) ? c : mine; }
        if (sum == G) break;
        __builtin_amdgcn_s_sleep(1);
        if ((++sp & 255u) == 0u) { if (xb_ld(&bar[XB_TMO])) break; if (sp > XB_SPIN_CAP) { atomicAdd(&bar[XB_TMO], 1u); break; } }
    }
    nloc = mine > 0u ? mine : 1u; nx = cnt > 0u ? cnt : 1u;
}

__device__ __forceinline__ void xcd_barrier(const XcdBarrier& b) {
    asm volatile("s_waitcnt vmcnt(0)" ::: "memory");
    __syncthreads();
    if (threadIdx.x == 0) {
        unsigned* bar = b.bar;
        __builtin_amdgcn_s_waitcnt(0);
        unsigned nloc = b.st[0], nx = b.st[1];
        if (nloc == 0u) { xcd_barrier_complete(bar, b.x, nloc, nx); b.st[0] = nloc; b.st[1] = nx; }
        const unsigned old = xb_add(&bar[XB_XSUB(b.x)], 1u);
        const unsigned gen = old / nloc;
        if (old + 1u == (gen + 1u) * nloc) {
            __builtin_amdgcn_fence(__ATOMIC_RELEASE, "agent");
            asm volatile("s_waitcnt vmcnt(0)" ::: "memory");
            const unsigned og = xb_add(&bar[XB_TOP], 1u);
            const unsigned tg = og / nx;
            if (og + 1u == (tg + 1u) * nx) xb_add(&bar[XB_TOPGEN], 1u);
            else XB_SPIN(xb_ld(&bar[XB_TOPGEN]) == tg, bar);
            __builtin_amdgcn_fence(__ATOMIC_ACQUIRE, "agent");
            xb_add(&bar[XB_XGEN(b.x)], 1u);
            asm volatile("s_waitcnt vmcnt(0)" ::: "memory");
        } else {
            XB_SPIN(xb_ld(&bar[XB_XGEN(b.x)]) == gen, bar);
            __builtin_amdgcn_fence(__ATOMIC_ACQUIRE, "agent");
            asm volatile("s_waitcnt vmcnt(0)" ::: "memory");
        }
    }
    __syncthreads();
}

__global__ void __launch_bounds__(512, 2) fwd_megakernel(Params p) {
    extern __shared__ __attribute__((aligned(16))) unsigned char lds_raw[];
    LAS unsigned char* lds = (LAS unsigned char*)lds_raw;
    cg::grid_group grid = cg::this_grid();
    const int tid = threadIdx.x, lane = tid & 63, wave = __builtin_amdgcn_readfirstlane(tid >> 6);
    const int G = gridDim.x, gw = blockIdx.x * 8 + wave, NGW = G * 8;
    unsigned char* ws = p.ws;
    bf16_t* XO = (bf16_t*)(ws + WS_XO); bf16_t* BIG = (bf16_t*)(ws + WS_BIG); bf16_t* QM = (bf16_t*)(ws + WS_QKVM);
    float* hmeta_adj = (float*)(ws + WS_HMETA) - (size_t)NREAL * D;

#if PH & 1
    if (tid < 2) ((volatile LAS unsigned*)(lds + 131072 + 16))[tid] = 0u;
    __syncthreads();
    const XcdBarrier xbar = xcd_barrier_post((unsigned*)(ws + WS_CTL) + 4096, (volatile LAS unsigned*)(lds + 131072 + 16));
    prologue(p, lds, gw, NGW, wave, lane);
#endif
#if PH & 2
    norm_rows<1>(p, p.in[3], gw, NGW, lane);
#endif
    grid.sync();
#define RESID_GEMM_NORM(GA, GB, GK, GLDA, EPI, NEXT_G, META) do { \
        { pg8::Gemm g_{GA, GB, NREAL, 1024, GK, GLDA}; pg8::StaticOrder S_; S_.init(NREAL, 1024, G, (int)blockIdx.x); pg8::gemm_phase(lds, g_, S_, EPI); } \
        xcd_barrier(xbar); \
        if ((NEXT_G) != nullptr && !(META)) { norm_rows<0>(p, NEXT_G, gw, NGW, lane, 0, NREAL, 0); xcd_barrier(xbar); } \
        else if ((NEXT_G) != nullptr) { \
            if (blockIdx.x < 8) { pg8::Gemm g_{GA, GB, MP, 1024, GK, GLDA}; pg8::MetaOrder S_{(int)blockIdx.x}; pg8::gemm_phase(lds, g_, S_, EPI); } \
            else norm_rows<0>(p, NEXT_G, gw, (G - 8) * 8, lane, 0, NREAL, 8); \
            xcd_barrier(xbar); \
            norm_rows<0>(p, NEXT_G, gw, NGW, lane, NREAL, MP, 0); \
            xcd_barrier(xbar); } } while (0)
#pragma unroll 1
    for (int l = 0; l < 2; ++l) {
#pragma unroll 1
        for (int f = 0; f < 2; ++f) {
            { const int Mg = (l == 1 && f == 1) ? NREAL : MP;
              pg8::Gemm g{XO, (const bf16_t*)(ws + WS_WGU) + (size_t)(l * 2 + f) * 5632 * 1024, Mg, 5632, 1024, 1024}; pg8::StaticOrder S; S.init(Mg, 5632, G, (int)blockIdx.x);
              pg8::EpiSwiGLU E{BIG, DFF}; pg8::gemm_phase(lds, g, S, E); }
            xcd_barrier(xbar);
            { pg8::EpiResid E{p.out, hmeta_adj, 0.5f, (l == 0 && f == 0) ? p.in[0] : nullptr, p.in[1] - (size_t)65536 * D};
              const float* next_g = (f == 0) ? p.in[3] + (l * 3 + 1) * D : (l == 0 ? p.in[3] + 3 * D : (const float*)nullptr);
              RESID_GEMM_NORM(BIG, (const bf16_t*)(ws + WS_WDN) + (size_t)(l * 2 + f) * 1024 * 2816, 2816, 2816, E, next_g, true); }
            if (f == 0) {
                { pg8::Gemm g{XO, (const bf16_t*)(ws + WS_WIN) + (size_t)l * 2816 * 1024, MP, 2816, 1024, 1024}; pg8::StaticOrder S; S.init(MP, 2816, G, (int)blockIdx.x);
                  pg8::EpiU E{BIG, p.in[13] + l * 256, p.in[14] + l * 128, (const float*)(ws + WS_TABD), (const float*)(ws + WS_TABD) + 8208 * 4, (const float*)(ws + WS_TABM), (const float*)(ws + WS_TABM) + 8208 * 16, (LAS float*)(lds + EPIU_X_OFF)};
                  pg8::gemm_phase(lds, g, S, E); }
                xcd_barrier(xbar);
                { pg8::Gemm g{BIG + U_CQ, (const bf16_t*)(ws + WS_WMLA) + (size_t)l * 1024 * 384, MP, 1024, 384, INP}; pg8::StaticOrder S; S.init(MP, 1024, G, (int)blockIdx.x);
                  pg8::EpiBf16 E{QM, 1024}; pg8::gemm_phase(lds, g, S, E); }
                xcd_barrier(xbar);
                attn_phase(lds, p, l, l);
                xcd_barrier(xbar);
                { pg8::EpiResid E{p.out, hmeta_adj, 1.0f, nullptr, nullptr};
                  RESID_GEMM_NORM(XO, (const bf16_t*)(ws + WS_WOUT) + (size_t)l * 1024 * 1024, 1024, 1024, E, p.in[3] + (l * 3 + 2) * D, l == 0); }
            }
        }
    }
#undef RESID_GEMM_NORM
#if PH & 512
    final_rows(p, gw, NGW, lane);
#endif
}

extern "C" void kernel_launch(void* const* d_in, const int* in_sizes, int n_in, void* d_out, int out_size, void* d_ws, size_t ws_size, hipStream_t stream) {
    static int grid = 0;
    if (grid == 0) {
        if (n_in != 17 || ws_size < WS_END) { fprintf(stderr, "kernel_launch: unexpected n_in %d / ws_size %zu (need %zu)\n", n_in, ws_size, (size_t)WS_END); grid = -1; return; }
        int dev = 0, cus = 0, per_cu = 0;
        hipGetDevice(&dev);
        hipDeviceGetAttribute(&cus, hipDeviceAttributeMultiprocessorCount, dev);
        hipFuncSetAttribute((const void*)fwd_megakernel, hipFuncAttributeMaxDynamicSharedMemorySize, LDS_BYTES);
        hipOccupancyMaxActiveBlocksPerMultiprocessor(&per_cu, (const void*)fwd_megakernel, 512, LDS_BYTES);
        if (per_cu < 1) { fprintf(stderr, "kernel_launch: occupancy query returned %d\n", per_cu); per_cu = 1; }
        grid = cus * 1;
        (void)hipGetLastError();
    }
    if (grid < 0) return;
    hipMemsetAsync((char*)d_ws + WS_CTL, 0, 32768, stream);
    Params p{};
    for (int i = 0; i < 17; ++i) p.in[i] = (const float*)d_in[i];
    p.out = (float*)d_out; p.ws = (unsigned char*)d_ws;
    void* args[] = {&p};
    hipError_t e = hipLaunchCooperativeKernel((const void*)fwd_megakernel, dim3(grid), dim3(512), args, LDS_BYTES, stream);
    if (e != hipSuccess) fprintf(stderr, "cooperative launch failed: %s (grid %d)\n", hipGetErrorString(e), grid);
}
```
